# Optimizing an MI355X kernel written in HIP

```python
import jax, jax.numpy as jnp
from jax import lax
import numpy as np

D_MODEL = 2048
BATCH = 1
SEQ = 8192
DEPTH = 1

D_PLE = 256
N_Q_HEADS = 16
N_KV_HEADS = 4
HEAD_DIM = 64
WINDOW = 128
ATTN_BLOCK = 128
N_SG_HEADS = 8
SG_HEAD_DIM = 128
SG_CHUNK = 128
D_ATTN = N_Q_HEADS * HEAD_DIM
D_KV = N_KV_HEADS * HEAD_DIM
D_SG = N_SG_HEADS * SG_HEAD_DIM
D_MIX = D_ATTN + D_SG
D_IN = D_ATTN + 2 * D_KV + 2 * D_SG
N_EXPERTS = 32
TOP_K = 4
D_FF = D_MODEL
SWIGLU_LIMIT = 7.0
SWIGLU_ALPHA = 1.702
MOE_BLOCK = 128
EPS = 1e-6

kernel_name = "hymba_swa_sink_gmlp_moe_ple"


def rms_norm(x, g):
    xf = x.astype(jnp.float32)
    y = xf * lax.rsqrt(jnp.mean(xf * xf, axis=-1, keepdims=True) + EPS)
    return (y * g.astype(jnp.float32)).astype(x.dtype)


def layer_norm(x, g, b):
    xf = x.astype(jnp.float32)
    mu = jnp.mean(xf, axis=-1, keepdims=True)
    var = jnp.mean(jnp.square(xf - mu), axis=-1, keepdims=True)
    y = (xf - mu) * lax.rsqrt(var + EPS)
    return (y * g.astype(jnp.float32) + b.astype(jnp.float32)).astype(x.dtype)


def sliding_window_sink_attention(q, k, v, sinks):
    bsz, s = q.shape[0], q.shape[1]
    nb = s // ATTN_BLOCK
    grp = N_Q_HEADS // N_KV_HEADS
    qb = q.reshape(bsz, nb, ATTN_BLOCK, N_KV_HEADS, grp, HEAD_DIM)
    kb = k.reshape(bsz, nb, ATTN_BLOCK, N_KV_HEADS, HEAD_DIM)
    vb = v.reshape(bsz, nb, ATTN_BLOCK, N_KV_HEADS, HEAD_DIM)

    def with_prev(t):
        prev = jnp.pad(t[:, :-1], ((0, 0), (1, 0), (0, 0), (0, 0), (0, 0)))
        return jnp.concatenate([prev, t], axis=2)

    kk, vv = with_prev(kb), with_prev(vb)
    scores = jnp.einsum('bnqkgd,bnskd->bnkgqs', qb, kk).astype(jnp.float32) * (HEAD_DIM ** -0.5)
    qi = jnp.arange(ATTN_BLOCK)[:, None]
    sj = jnp.arange(2 * ATTN_BLOCK)[None, :]
    rel = sj - ATTN_BLOCK - qi
    band = (rel <= 0) & (rel > -WINDOW)
    has_prev = (jnp.arange(nb)[:, None, None] > 0) | (sj[None] >= ATTN_BLOCK)
    mask = band[None] & has_prev
    scores = jnp.where(mask[None, :, None, None], scores, jnp.float32(-1e30))
    sink = sinks.astype(jnp.float32).reshape(N_KV_HEADS, grp)[None, None, :, :, None, None]
    sink = jnp.broadcast_to(sink, scores.shape[:-1] + (1,))
    probs = jax.nn.softmax(jnp.concatenate([scores, sink], axis=-1), axis=-1)[..., :-1]
    out = jnp.einsum('bnkgqs,bnskd->bnqkgd', probs.astype(v.dtype), vv)
    return out.reshape(bsz, s, D_ATTN)


def chunked_spatial_gating(u, v, ln_g, ln_b, w_s, b_s):
    bsz, s = u.shape[0], u.shape[1]
    nc = s // SG_CHUNK
    u = jax.nn.gelu(u, approximate=False)
    v = layer_norm(jax.nn.gelu(v, approximate=False), ln_g, ln_b)
    vc = v.reshape(bsz, nc, SG_CHUNK, N_SG_HEADS, SG_HEAD_DIM)
    causal = jnp.tril(jnp.ones((SG_CHUNK, SG_CHUNK), dtype=bool))
    w = jnp.where(causal[None], w_s, jnp.zeros_like(w_s))
    mixed = jnp.einsum('gts,bnsgc->bntgc', w, vc) + b_s.T[None, None, :, :, None]
    return u * mixed.reshape(bsz, s, D_SG)


def moe_ffn(xn, w_router, b_router, w_gate_up, b_gate_up, w_down, b_down):
    bsz, s, d = xn.shape
    t = bsz * s
    xt = xn.reshape(t, d)
    logits = (xt @ w_router + b_router).astype(jnp.float32)
    top_val, top_idx = lax.top_k(logits, TOP_K)
    gates = jax.nn.softmax(top_val, axis=-1)
    tk = t * TOP_K
    e_flat = top_idx.reshape(tk).astype(jnp.int32)
    tok_flat = (jnp.arange(tk, dtype=jnp.int32) // TOP_K)
    g_flat = gates.reshape(tk)
    order = jnp.argsort(e_flat, stable=True)
    sorted_e = e_flat[order]
    counts = jnp.bincount(e_flat, length=N_EXPERTS).astype(jnp.int32)
    padded = (counts + MOE_BLOCK - 1) // MOE_BLOCK * MOE_BLOCK
    pad_end = jnp.cumsum(padded)
    pad_start = pad_end - padded
    start = jnp.cumsum(counts) - counts
    dest = pad_start[sorted_e] + jnp.arange(tk, dtype=jnp.int32) - start[sorted_e]
    nblk = -(-tk // MOE_BLOCK) + N_EXPERTS
    rows = nblk * MOE_BLOCK
    row_tok = jnp.full((rows,), t, dtype=jnp.int32).at[dest].set(tok_flat[order])
    row_gate = jnp.zeros((rows,), jnp.float32).at[dest].set(g_flat[order])
    blk_start = jnp.arange(nblk, dtype=jnp.int32) * MOE_BLOCK
    blk_expert = jnp.minimum(jnp.searchsorted(pad_end, blk_start, side='right'), N_EXPERTS - 1).astype(jnp.int32)
    x_pad = jnp.concatenate([xt, jnp.zeros((1, d), xt.dtype)], axis=0)
    xb = x_pad[row_tok].reshape(nblk, MOE_BLOCK, d)

    def expert_block(args):
        xblk, e = args
        h = xblk @ w_gate_up[e] + b_gate_up[e]
        gate, up = h[:, ::2], h[:, 1::2]
        gate = jnp.minimum(gate, SWIGLU_LIMIT)
        up = jnp.clip(up, -SWIGLU_LIMIT, SWIGLU_LIMIT)
        glu = gate * jax.nn.sigmoid(gate * SWIGLU_ALPHA)
        return ((up + 1) * glu) @ w_down[e] + b_down[e]

    yb = lax.map(expert_block, (xb, blk_expert))
    yw = yb.reshape(rows, d) * row_gate[:, None].astype(yb.dtype)
    y = jax.ops.segment_sum(yw, row_tok, num_segments=t + 1)[:t]
    return y.reshape(bsz, s, d)


def hybrid_layer(x, p_i, ln1_g, w_in, q_norm_g, k_norm_g, sinks, sg_ln_g, sg_ln_b,
                 w_spatial, b_spatial, attn_out_g, sg_out_g, w_out, ln2_g,
                 w_router, b_router, w_gate_up, b_gate_up, w_down, b_down,
                 w_ple, ple_norm_g, w_ple_gate):
    bsz, s, _ = x.shape
    hn = rms_norm(x, ln1_g)
    proj = hn @ w_in
    splits = [D_ATTN, D_ATTN + D_KV, D_ATTN + 2 * D_KV, D_ATTN + 2 * D_KV + D_SG]
    q, k, v, u, vg = jnp.split(proj, splits, axis=-1)
    q = rms_norm(q.reshape(bsz, s, N_Q_HEADS, HEAD_DIM), q_norm_g)
    k = rms_norm(k.reshape(bsz, s, N_KV_HEADS, HEAD_DIM), k_norm_g)
    v = v.reshape(bsz, s, N_KV_HEADS, HEAD_DIM)
    a = sliding_window_sink_attention(q, k, v, sinks)
    sg = chunked_spatial_gating(u, vg, sg_ln_g, sg_ln_b, w_spatial, b_spatial)
    merged = jnp.concatenate([rms_norm(a, attn_out_g), rms_norm(sg, sg_out_g)], axis=-1)
    h = x + merged @ w_out
    h = h + moe_ffn(rms_norm(h, ln2_g), w_router, b_router, w_gate_up, b_gate_up, w_down, b_down)
    gate = jax.nn.sigmoid(rms_norm(h, ple_norm_g) @ w_ple_gate)
    return h + (p_i @ w_ple) * gate


def setup_inputs(seed: int = 0) -> dict:
    key = jax.random.key(seed)
    ks = jax.random.split(key, 32)
    f32 = jnp.float32

    def nrm(k, shape, scale):
        return jax.random.normal(k, shape, f32) * scale

    def gain(k, shape):
        return 1.0 + 0.1 * jax.random.normal(k, shape, f32)

    L = DEPTH
    return {
        "x": jax.random.normal(ks[0], (BATCH, SEQ, D_MODEL), f32),
        "p": jax.random.normal(ks[1], (DEPTH, BATCH, SEQ, D_PLE), f32),
        "ln1_g": gain(ks[2], (L, D_MODEL)),
        "w_in": nrm(ks[3], (L, D_MODEL, D_IN), D_MODEL ** -0.5),
        "q_norm_g": gain(ks[4], (L, HEAD_DIM)),
        "k_norm_g": gain(ks[5], (L, HEAD_DIM)),
        "sinks": nrm(ks[6], (L, N_Q_HEADS), 1.0),
        "sg_ln_g": gain(ks[7], (L, D_SG)),
        "sg_ln_b": nrm(ks[8], (L, D_SG), 0.02),
        "w_spatial": nrm(ks[9], (L, N_SG_HEADS, SG_CHUNK, SG_CHUNK), 0.5 * SG_CHUNK ** -0.5),
        "b_spatial": gain(ks[10], (L, N_SG_HEADS, SG_CHUNK)),
        "attn_out_g": gain(ks[11], (L, D_ATTN)),
        "sg_out_g": gain(ks[12], (L, D_SG)),
        "w_out": nrm(ks[13], (L, D_MIX, D_MODEL), D_MIX ** -0.5),
        "ln2_g": gain(ks[14], (L, D_MODEL)),
        "w_router": nrm(ks[15], (L, D_MODEL, N_EXPERTS), D_MODEL ** -0.5),
        "b_router": nrm(ks[16], (L, N_EXPERTS), 0.01),
        "w_gate_up": nrm(ks[17], (L, N_EXPERTS, D_MODEL, 2 * D_FF), D_MODEL ** -0.5),
        "b_gate_up": nrm(ks[18], (L, N_EXPERTS, 2 * D_FF), 0.02),
        "w_down": nrm(ks[19], (L, N_EXPERTS, D_FF, D_MODEL), D_FF ** -0.5),
        "b_down": nrm(ks[20], (L, N_EXPERTS, D_MODEL), 0.02),
        "w_ple": nrm(ks[21], (L, D_PLE, D_MODEL), D_PLE ** -0.5),
        "ple_norm_g": gain(ks[22], (L, D_MODEL)),
        "w_ple_gate": nrm(ks[23], (L, D_MODEL, D_MODEL), D_MODEL ** -0.5),
    }


def reference(x, p, ln1_g, w_in, q_norm_g, k_norm_g, sinks, sg_ln_g, sg_ln_b,
              w_spatial, b_spatial, attn_out_g, sg_out_g, w_out, ln2_g,
              w_router, b_router, w_gate_up, b_gate_up, w_down, b_down,
              w_ple, ple_norm_g, w_ple_gate):
    h = x
    for i in range(DEPTH):
        h = hybrid_layer(h, p[i], ln1_g[i], w_in[i], q_norm_g[i], k_norm_g[i], sinks[i],
                         sg_ln_g[i], sg_ln_b[i], w_spatial[i], b_spatial[i],
                         attn_out_g[i], sg_out_g[i], w_out[i], ln2_g[i],
                         w_router[i], b_router[i], w_gate_up[i], b_gate_up[i],
                         w_down[i], b_down[i], w_ple[i], ple_norm_g[i], w_ple_gate[i])
    return h
```

```cpp
#include <hip/hip_runtime.h>
#include <stdint.h>
#include <cstdio>

constexpr int T = 8192, DM = 2048, DPLE = 256;
constexpr int NQH = 16, NKVH = 4, HD = 64, WIN = 128;
constexpr int NSG = 8, SGD = 128, SGC = 128;
constexpr int DATT = 1024, DKV = 256, DSG = 1024, DIN = 3584;
constexpr int NE = 32, TOPK = 4, DFF = 2048;
constexpr float EPS = 1e-6f;
constexpr int QOFF = 0, KOFF = 1024, VOFF = 1280, UOFF = 1536, GOFF = 2560;
constexpr int CAP = T;
constexpr int MAXROWS = T * TOPK + NE * 256;

#define GAS __attribute__((address_space(1)))
#define LAS __attribute__((address_space(3)))
typedef unsigned short bf16_t;
typedef short bf16x8 __attribute__((ext_vector_type(8)));
typedef float f32x4 __attribute__((ext_vector_type(4)));
typedef float f32x2 __attribute__((ext_vector_type(2)));
typedef float f32x16 __attribute__((ext_vector_type(16)));
typedef unsigned u32x4 __attribute__((ext_vector_type(4)));
typedef unsigned u32x2 __attribute__((ext_vector_type(2)));

__device__ __forceinline__ unsigned cvt_pk_bf16(float lo, float hi) { unsigned r; asm volatile("v_cvt_pk_bf16_f32 %0, %1, %2" : "=v"(r) : "v"(lo), "v"(hi)); return r; }
__device__ __forceinline__ float bf2f(unsigned short b) { return __builtin_bit_cast(float, (unsigned)b << 16); }
__device__ __forceinline__ float bflo(unsigned w) { return __builtin_bit_cast(float, w << 16); }
__device__ __forceinline__ float bfhi(unsigned w) { return __builtin_bit_cast(float, w & 0xffff0000u); }
__device__ __forceinline__ float wave_sum(float v) {
#pragma unroll
    for (int o = 32; o > 0; o >>= 1) v += __shfl_xor(v, o);
    return v;
}
#define LDS_WAIT() asm volatile("s_waitcnt lgkmcnt(0)" ::: "memory")
#define VM_WAIT() asm volatile("s_waitcnt vmcnt(0)" ::: "memory")

constexpr size_t MiB = 1u << 20;
constexpr size_t WS_CTL = 0, CTL_ZERO_BYTES = 65536;
constexpr size_t WS_WIN = 2 * MiB;
constexpr size_t WS_WOUT = 16 * MiB;
constexpr size_t WS_WPG = 24 * MiB;
constexpr size_t WS_WPLE = 32 * MiB;
constexpr size_t WS_WSP = 33 * MiB;
constexpr size_t WS_WR = 34 * MiB;
constexpr size_t WS_STATS = 35 * MiB;
constexpr size_t WS_ASS = 36 * MiB;
constexpr size_t WS_SSS = 37 * MiB;
constexpr size_t WS_RS = 38 * MiB;
constexpr size_t WS_TOKINFO = 39 * MiB;
constexpr size_t WS_ROWTOK = 40 * MiB;
constexpr size_t WS_ROWRS = 41 * MiB;
constexpr size_t WS_XB = 48 * MiB;
constexpr size_t WS_PB = 80 * MiB;
constexpr size_t WS_PE = 84 * MiB;
constexpr size_t WS_PROJ = 116 * MiB;
constexpr size_t WS_MG = 172 * MiB;
constexpr size_t WS_HB = 204 * MiB;
constexpr size_t WS_H2B = 236 * MiB;
constexpr size_t WS_ACT = 268 * MiB;
constexpr size_t WS_Y = 432 * MiB;
constexpr size_t WS_WGU = 600 * MiB;
constexpr size_t WS_WDN = 1112 * MiB;
constexpr size_t WS_HF = 1368 * MiB;
constexpr size_t WS_H2F = 1432 * MiB;
constexpr size_t WS_END = 1496 * MiB;

constexpr int CW_CNT = 64;
constexpr int CW_BAR = 4096;
constexpr int CW_BAR2 = 12288;
constexpr int CW_QHEAD = 8192;
constexpr int CW_DONE = 8192 + 64;

#define XB_TMO      128
#define XB_XCNT(j)  (256  + 64 * (j))
#define XB_XSUB(j)  (1280 + 64 * (j))
#define XB_XGEN(j)  (2304 + 64 * (j))
#define XB_TOP      3328
#define XB_TOPGEN   3392
#define XCD_BAR_WORDS 3456
#define XB_SPIN_CAP (1u << 18)
__device__ __forceinline__ unsigned xb_ld(unsigned* p)              { return __hip_atomic_load(p, __ATOMIC_RELAXED, __HIP_MEMORY_SCOPE_AGENT); }
__device__ __forceinline__ unsigned xb_add(unsigned* p, unsigned v) { return __hip_atomic_fetch_add(p, v, __ATOMIC_RELAXED, __HIP_MEMORY_SCOPE_AGENT); }
__device__ __forceinline__ unsigned xb_xcc_id() { return (unsigned)__builtin_amdgcn_s_getreg((3 << 11) | 20) & 0xFu; }
#define XB_SPIN(cond, bar) do { unsigned _sp = 0; while (cond) { __builtin_amdgcn_s_sleep(1); \
    if ((++_sp & 255u) == 0u) { if (xb_ld(&(bar)[XB_TMO])) break; if (_sp > XB_SPIN_CAP) { atomicAdd(&(bar)[XB_TMO], 1u); break; } } } } while (0)
struct XcdBarrier { unsigned* bar; unsigned x; volatile LAS unsigned* st; unsigned total; };
__device__ __forceinline__ XcdBarrier xcd_barrier_post(unsigned* bar, volatile LAS unsigned* st, unsigned total) {
    XcdBarrier b; b.bar = bar; b.x = xb_xcc_id(); b.st = st; b.total = total;
    if (threadIdx.x == 0) (void)xb_add(&bar[XB_XCNT(b.x)], 1u);
    return b;
}
__device__ __forceinline__ void xcd_barrier_complete(unsigned* bar, unsigned x, unsigned G, unsigned& nloc, unsigned& nx) {
    unsigned sum, cnt, mine, sp = 0u;
    for (;;) {
        sum = 0u; cnt = 0u; mine = 0u;
#pragma unroll
        for (unsigned j = 0; j < 16; ++j) { const unsigned c = xb_ld(&bar[XB_XCNT(j)]); sum += c; cnt += (c > 0u) ? 1u : 0u; mine = (j == x) ? c : mine; }
        if (sum == G) break;
        __builtin_amdgcn_s_sleep(1);
        if ((++sp & 255u) == 0u) { if (xb_ld(&bar[XB_TMO])) break; if (sp > XB_SPIN_CAP) { atomicAdd(&bar[XB_TMO], 1u); break; } }
    }
    nloc = mine > 0u ? mine : 1u; nx = cnt > 0u ? cnt : 1u;
}
__device__ __forceinline__ void xcd_barrier(const XcdBarrier& b) {
    asm volatile("s_waitcnt vmcnt(0)" ::: "memory");
    __syncthreads();
    if (threadIdx.x == 0) {
        unsigned* bar = b.bar;
        __builtin_amdgcn_s_waitcnt(0);
        unsigned nloc = b.st[0], nx = b.st[1];
        if (nloc == 0u) { xcd_barrier_complete(bar, b.x, b.total, nloc, nx); b.st[0] = nloc; b.st[1] = nx; }
        const unsigned old = xb_add(&bar[XB_XSUB(b.x)], 1u);
        const unsigned gen = old / nloc;
        if (old + 1u == (gen + 1u) * nloc) {
            __builtin_amdgcn_fence(__ATOMIC_RELEASE, "agent");
            asm volatile("s_waitcnt vmcnt(0)" ::: "memory");
            const unsigned og = xb_add(&bar[XB_TOP], 1u);
            const unsigned tg = og / nx;
            if (og + 1u == (tg + 1u) * nx) xb_add(&bar[XB_TOPGEN], 1u);
            else XB_SPIN(xb_ld(&bar[XB_TOPGEN]) == tg, bar);
            __builtin_amdgcn_fence(__ATOMIC_ACQUIRE, "agent");
            xb_add(&bar[XB_XGEN(b.x)], 1u);
            asm volatile("s_waitcnt vmcnt(0)" ::: "memory");
        } else {
            XB_SPIN(xb_ld(&bar[XB_XGEN(b.x)]) == gen, bar);
            __builtin_amdgcn_fence(__ATOMIC_ACQUIRE, "agent");
            asm volatile("s_waitcnt vmcnt(0)" ::: "memory");
        }
    }
    __syncthreads();
}

constexpr int NWAVES = 8;
constexpr int RING_BYTES = 131072;
constexpr int XTR_OFF = RING_BYTES;
constexpr int MISC_OFF = RING_BYTES + 28672;
constexpr int LDS_BYTES = 163840;

struct Args { const float* in[24]; float* out; unsigned char* ws; int ph_lo, ph_hi; };
#define REFRESH() do { int tz_ = threadIdx.x; asm volatile("" : "+v"(tz_)); F.tid = tz_; F.lane = tz_ & 63; } while (0)
struct Frame { LAS unsigned char* lds; volatile LAS unsigned* MISC; unsigned* ctl; int tid, lane, wave, G, vcu; int cG, cidx, cvcu; bool conv; };
namespace pg8 {
constexpr int BM = 256, BK = 64, HALF = 128, HTB = HALF * BK * 2, STAGE_BYTES = 8 * HTB, NXCD = 8, WGM = 8;
__host__ __device__ __forceinline__ int lds_byte(int r, int c) { const int st = (r >> 4) * 2 + (c >> 5), rr = r & 15, cc = c & 31, ob = rr * 64 + cc * 2; return st * 1024 + (ob ^ (((ob >> 9) & 1) << 5)); }
__host__ __device__ __forceinline__ void stage_rc(int b, int& R, int& C) { const int st = b / 1024, sb = b % 1024, swz = sb ^ (((sb >> 9) & 1) << 5); R = (st >> 1) * 16 + swz / 64; C = (st & 1) * 32 + (swz % 64) / 2; }
__host__ __device__ __forceinline__ int perm32(int rho) { const int n = rho >> 4, i = rho & 15; return 8 * (i >> 2) + 4 * n + (i & 3); }

struct Unit { int pm, pn, e, rows, idx; };
typedef int i32x4 __attribute__((ext_vector_type(4)));
typedef int i32x8 __attribute__((ext_vector_type(8)));
__device__ __forceinline__ i32x8 cat8(bf16x8 a, bf16x8 b) { const i32x4 x = __builtin_bit_cast(i32x4, a), y = __builtin_bit_cast(i32x4, b); return __builtin_shufflevector(x, y, 0, 1, 2, 3, 4, 5, 6, 7); }

struct DenseOrder {
    const char* A; const char* Bt; int rb; int nM, nN, nwg, G, c;
    __device__ void init(const void* A_, const void* Bt_, int M, int N, int rb_, int G_, int c_) { A = (const char*)A_; Bt = (const char*)Bt_; rb = rb_; nM = M / BM; nN = N / BM; nwg = nM * nN; G = G_; c = c_; }
    __device__ bool next(int i, Unit& u) const {
        const long L = (long)i * G + c; if (L >= nwg) return false;
        int wgid = (int)L; { const int q = nwg / NXCD, r = nwg % NXCD, xcd = wgid % NXCD, off = wgid / NXCD; wgid = (xcd < r ? xcd * (q + 1) : r * (q + 1) + (xcd - r) * q) + off; }
        const int nig = WGM * nN, gid = wgid / nig, fm = gid * WGM, gsz = (nM - fm) < WGM ? (nM - fm) : WGM;
        u.pm = fm + ((wgid % nig) % gsz); u.pn = (wgid % nig) / gsz; u.e = 0; u.rows = BM; u.idx = i; return true;
    }
    __device__ __forceinline__ const char* a_ptr(const Unit& u) const { return A + (size_t)u.pm * ((size_t)BM * rb); }
    __device__ __forceinline__ const char* b_ptr(const Unit& u) const { return Bt + (size_t)u.pn * ((size_t)BM * rb); }
    __device__ __forceinline__ unsigned gather_off(int, int) const { return 0u; }
};

template <class Epi, class Sched, bool ALIGN_EPI, bool GATHER, bool HOOK, bool F8 = false, bool HALFSKIP = false>
__device__ __forceinline__ void gemm_phase(LAS unsigned char* lds, const int KB, const Sched& S, const Epi& E) {
    const int tid = threadIdx.x, wid = __builtin_amdgcn_readfirstlane(tid >> 6), lane = tid & 63, wr = wid >> 2, wc = wid & 3, fr = lane & 15, fq = lane >> 4;
    const int nt = KB / 128;
    unsigned voffA[2], voffB[2]; int rowA[2];
#pragma unroll
    for (int i = 0; i < 2; ++i) { int R, C; stage_rc(tid * 16 + i * 8192, R, C); const int Rb = Epi::PERM ? ((R & ~31) + perm32(R & 31)) : R;
        voffA[i] = (unsigned)(R * KB + C * 2); voffB[i] = (unsigned)(Rb * KB + C * 2); rowA[i] = R; if (GATHER) voffA[i] = (unsigned)C * 2u; }
    const size_t kstep = (size_t)(BK * 2);
    const unsigned hstep = (unsigned)HALF * KB;
    const unsigned ldsw = (unsigned)wid * 1024u;
    const int aoff = lds_byte(wr * 64 + fr, fq * 8), boff = lds_byte(wc * 32 + fr, fq * 8);
#define PG8_SA(b, h) (((b) * 2 + (h)) * HTB)
#define PG8_SB(b, h) ((4 + (b) * 2 + (h)) * HTB)
#define PG8_STAGE_B(bufoff, gbase, hh) do { _Pragma("unroll") for (int _i = 0; _i < 2; ++_i) \
        __builtin_amdgcn_global_load_lds((const unsigned*)((const char*)(gbase) + (voffB[_i] + (hh) * hstep)), (LAS unsigned*)(lds + (bufoff) + ldsw + _i * 8192), 16, 0, 0); } while (0)
#define PG8_STAGE_A(bufoff, gbase, OFF, hh) do { _Pragma("unroll") for (int _i = 0; _i < 2; ++_i) \
        __builtin_amdgcn_global_load_lds((const unsigned*)((const char*)(gbase) + (OFF)[hh][_i]), (LAS unsigned*)(lds + (bufoff) + ldsw + _i * 8192), 16, 0, 0); } while (0)
#define PG8_LDA(dst, b, h) do { _Pragma("unroll") for (int m = 0; m < 4; ++m) { if constexpr (F8) dst##8[m] = __builtin_shufflevector(*(const LAS i32x4*)(lds + PG8_SA(b, h) + aoff + m * 2048), *(const LAS i32x4*)(lds + PG8_SA(b, h) + aoff + m * 2048 + 1024), 0, 1, 2, 3, 4, 5, 6, 7); \
        else { _Pragma("unroll") for (int k = 0; k < 2; ++k) dst[m][k] = *(const LAS bf16x8*)(lds + PG8_SA(b, h) + aoff + m * 2048 + k * 1024); } } } while (0)
#define PG8_LDB(dst, b, h) do { _Pragma("unroll") for (int n = 0; n < 2; ++n) { if constexpr (F8) dst##8[n] = __builtin_shufflevector(*(const LAS i32x4*)(lds + PG8_SB(b, h) + boff + n * 2048), *(const LAS i32x4*)(lds + PG8_SB(b, h) + boff + n * 2048 + 1024), 0, 1, 2, 3, 4, 5, 6, 7); \
        else { _Pragma("unroll") for (int k = 0; k < 2; ++k) dst[n][k] = *(const LAS bf16x8*)(lds + PG8_SB(b, h) + boff + n * 2048 + k * 1024); } } } while (0)
#define PG8_MMA(ai, bj, At, Bt) do { __builtin_amdgcn_s_setprio(1); _Pragma("unroll") for (int m = 0; m < 4; ++m) _Pragma("unroll") for (int n = 0; n < 2; ++n) { \
        if constexpr (F8) asm volatile("v_mfma_f32_16x16x128_f8f6f4 %0, %1, %2, %0" : "+v"(acc[ai][bj][m][n]) : "v"(Bt##8[n]), "v"(At##8[m])); \
        else { _Pragma("unroll") for (int k = 0; k < 2; ++k) acc[ai][bj][m][n] = __builtin_amdgcn_mfma_f32_16x16x32_bf16(Bt[n][k], At[m][k], acc[ai][bj][m][n], 0, 0, 0); } } \
        __builtin_amdgcn_s_setprio(0); } while (0)
#define PG8_WAIT_V(n) asm volatile("s_waitcnt vmcnt(" #n ")" ::: "memory")
#define PG8_WAIT_L(n) asm volatile("s_waitcnt lgkmcnt(" #n ")" ::: "memory")
#define PG8_BAR __builtin_amdgcn_s_barrier()
#define PG8_SCHED __builtin_amdgcn_sched_barrier(0)
    Unit cur, nxt; int ui = 0;
    if (!S.next(0, cur)) return;
    f32x4 acc[2][2][4][2];
#pragma unroll
    for (int a = 0; a < 2; ++a)
#pragma unroll
        for (int b = 0; b < 2; ++b)
#pragma unroll
            for (int m = 0; m < 4; ++m)
#pragma unroll
                for (int n = 0; n < 2; ++n) acc[a][b][m][n] = (f32x4){0.f, 0.f, 0.f, 0.f};
    bf16x8 At[4][2], B0[2][2], B1[2][2];
    i32x8 At8[4], B08[2], B18[2];
    const char* cA = S.a_ptr(cur); const char* cB = S.b_ptr(cur);
    unsigned offA[2][2], offN[2][2];
#pragma unroll
    for (int h = 0; h < 2; ++h)
#pragma unroll
        for (int i = 0; i < 2; ++i) { offA[h][i] = GATHER ? (S.gather_off(0, h * HALF + rowA[i]) + voffA[i]) : (voffA[i] + h * hstep); offN[h][i] = offA[h][i]; }
    PG8_STAGE_B(PG8_SB(0, 0), cB, 0); PG8_STAGE_B(PG8_SB(0, 1), cB, 1); PG8_STAGE_A(PG8_SA(0, 0), cA, offA, 0); PG8_STAGE_A(PG8_SA(0, 1), cA, offA, 1);
    if (wr == 1) PG8_BAR;
    PG8_WAIT_V(2); PG8_BAR;
    PG8_STAGE_B(PG8_SB(1, 0), cB + kstep, 0); PG8_STAGE_A(PG8_SA(1, 0), cA + kstep, offA, 0); PG8_STAGE_B(PG8_SB(1, 1), cB + kstep, 1);
    PG8_WAIT_V(6); PG8_BAR;
    for (;;) {
        const bool has_next = S.next(ui + 1, nxt);
        const char* nA = has_next ? S.a_ptr(nxt) : cA; const char* nB = has_next ? S.b_ptr(nxt) : cB;
        if (GATHER) {
#pragma unroll
            for (int h = 0; h < 2; ++h)
#pragma unroll
                for (int i = 0; i < 2; ++i) offN[h][i] = has_next ? (S.gather_off(ui + 1, h * HALF + rowA[i]) + voffA[i]) : offA[h][i];
        }
        const bool full = cur.rows > HALF;
        for (int t = 0; t < nt; t += 2) {
            const bool last = (t == nt - 2);
            const char* a1 = cA + (size_t)(t + 1) * kstep;
            const char* a2 = last ? nA : cA + (size_t)(t + 2) * kstep; const char* b2 = last ? nB : cB + (size_t)(t + 2) * kstep;
            const char* a3 = a2 + kstep; const char* b3 = b2 + kstep;
            unsigned o2[2][2];
#pragma unroll
            for (int h = 0; h < 2; ++h)
#pragma unroll
                for (int i = 0; i < 2; ++i) o2[h][i] = (GATHER && last) ? offN[h][i] : offA[h][i];
            if (HOOK) { if (t == nt / 2) E.hook(acc, cur, wr, wc, fr, fq); }
            PG8_LDB(B0, 0, 0); PG8_LDB(B1, 0, 1); PG8_SCHED; PG8_LDA(At, 0, 0); PG8_STAGE_A(PG8_SA(1, 1), a1, offA, 1);
            PG8_WAIT_V(8); PG8_WAIT_L(0); PG8_BAR; PG8_MMA(0, 0, At, B0); PG8_MMA(0, 1, At, B1); PG8_BAR; PG8_SCHED;
            PG8_LDA(At, 0, 1); PG8_STAGE_B(PG8_SB(0, 0), b2, 0); PG8_STAGE_B(PG8_SB(0, 1), b2, 1); PG8_STAGE_A(PG8_SA(0, 0), a2, o2, 0);
            PG8_WAIT_V(8); PG8_WAIT_L(0); PG8_BAR; if (!HALFSKIP || full) { PG8_MMA(1, 0, At, B0); PG8_MMA(1, 1, At, B1); } PG8_BAR; PG8_SCHED;
            PG8_LDB(B0, 1, 0); PG8_LDB(B1, 1, 1); PG8_SCHED; PG8_LDA(At, 1, 0); PG8_STAGE_A(PG8_SA(0, 1), a2, o2, 1);
            PG8_WAIT_V(8); PG8_WAIT_L(0); PG8_BAR; PG8_MMA(0, 0, At, B0); PG8_MMA(0, 1, At, B1); PG8_BAR; PG8_SCHED;
            PG8_LDA(At, 1, 1); PG8_STAGE_B(PG8_SB(1, 0), b3, 0); PG8_STAGE_B(PG8_SB(1, 1), b3, 1); PG8_STAGE_A(PG8_SA(1, 0), a3, o2, 0);
            PG8_WAIT_V(8); PG8_WAIT_L(0); PG8_BAR; if (!HALFSKIP || full) { PG8_MMA(1, 0, At, B0); PG8_MMA(1, 1, At, B1); } PG8_BAR; PG8_SCHED;
        }
        if constexpr (ALIGN_EPI) { if (wr == 0) PG8_BAR; }
        if constexpr (F8) asm volatile("s_nop 15\n\ts_nop 7" ::: "memory");
        E(acc, cur, wr, wc, fr, fq);
        if (!has_next) break;
#pragma unroll
        for (int a = 0; a < 2; ++a)
#pragma unroll
            for (int b = 0; b < 2; ++b)
#pragma unroll
                for (int m = 0; m < 4; ++m)
#pragma unroll
                    for (int n = 0; n < 2; ++n) acc[a][b][m][n] = (f32x4){0.f, 0.f, 0.f, 0.f};
        cur = nxt; cA = nA; cB = nB; ++ui;
#pragma unroll
        for (int h = 0; h < 2; ++h)
#pragma unroll
            for (int i = 0; i < 2; ++i) offA[h][i] = offN[h][i];
        if constexpr (ALIGN_EPI) { if (wr == 1) PG8_BAR; }
    }
    PG8_WAIT_V(0);
    if constexpr (!ALIGN_EPI) { if (wr == 0) PG8_BAR; }
    PG8_BAR;
#undef PG8_SA
#undef PG8_SB
#undef PG8_STAGE_A
#undef PG8_STAGE_B
#undef PG8_LDA
#undef PG8_LDB
#undef PG8_MMA
#undef PG8_WAIT_V
#undef PG8_WAIT_L
#undef PG8_BAR
#undef PG8_SCHED
}

__device__ __forceinline__ f32x2 gelu_pk(f32x2 v) {
    const f32x2 av = __builtin_elementwise_abs(v), d = av * 0.2316418882f + 1.0f;
    f32x2 t; t.x = __builtin_amdgcn_rcpf(d.x); t.y = __builtin_amdgcn_rcpf(d.y);
    f32x2 q = t * 0.5307027145f + (-0.7265760135f); q = q * t + 0.7107068705f; q = q * t + (-0.142248368f); q = q * t + 0.127414796f; q = q * t;
    const f32x2 s = (v * v) * (-0.72134752044f);
    f32x2 e; e.x = __builtin_amdgcn_exp2f(s.x); e.y = __builtin_amdgcn_exp2f(s.y);
    const f32x2 m = v * (q * e), r = v - m;
    f32x2 o; o.x = v.x < 0.f ? m.x : r.x; o.y = v.y < 0.f ? m.y : r.y; return o;
}

struct EpiProj {
    static constexpr bool PERM = true;
    bf16_t* O; float* stats;
    __device__ __forceinline__ void hook(f32x4 (&)[2][2][4][2], const Unit&, int, int, int, int) const {}
    __device__ __forceinline__ void operator()(f32x4 (&acc)[2][2][4][2], const Unit& u, int wr, int wc, int fr, int fq) const {
        const int row0 = u.pm * BM + wr * 64 + fr, col0 = u.pn * BM + wc * 32 + 8 * fq;
        const bool act = (u.pn * BM >= UOFF), st = (u.pn * BM >= GOFF);
#pragma unroll
        for (int ai = 0; ai < 2; ++ai)
#pragma unroll
            for (int m = 0; m < 4; ++m) {
                const int row = row0 + ai * HALF + m * 16;
                bf16_t* rowp = O + (size_t)row * DIN + col0;
                float s = 0.f, ss = 0.f;
#pragma unroll
                for (int bj = 0; bj < 2; ++bj) {
                    f32x4 v0 = acc[ai][bj][m][0], v1 = acc[ai][bj][m][1];
                    if (act) { f32x2 a = gelu_pk((f32x2){v0[0], v0[1]}), b = gelu_pk((f32x2){v0[2], v0[3]}), c = gelu_pk((f32x2){v1[0], v1[1]}), d = gelu_pk((f32x2){v1[2], v1[3]});
                        v0 = (f32x4){a.x, a.y, b.x, b.y}; v1 = (f32x4){c.x, c.y, d.x, d.y}; }
                    u32x4 w; w.x = cvt_pk_bf16(v0[0], v0[1]); w.y = cvt_pk_bf16(v0[2], v0[3]); w.z = cvt_pk_bf16(v1[0], v1[1]); w.w = cvt_pk_bf16(v1[2], v1[3]);
                    *(u32x4*)(rowp + bj * HALF) = w;
                    if (st) {
                        const float e0 = bflo(w.x), e1 = bfhi(w.x), e2 = bflo(w.y), e3 = bfhi(w.y), e4 = bflo(w.z), e5 = bfhi(w.z), e6 = bflo(w.w), e7 = bfhi(w.w);
                        s += ((e0 + e1) + (e2 + e3)) + ((e4 + e5) + (e6 + e7));
                        ss += ((e0 * e0 + e1 * e1) + (e2 * e2 + e3 * e3)) + ((e4 * e4 + e5 * e5) + (e6 * e6 + e7 * e7)); }
                }
                if (st) {
                    s += __shfl_xor(s, 16); ss += __shfl_xor(ss, 16); s += __shfl_xor(s, 32); ss += __shfl_xor(ss, 32);
                    if (fq == 0) *(f32x2*)(stats + ((size_t)row * 16 + (u.pn - GOFF / BM) * 4 + wc) * 2) = (f32x2){s, ss};
                }
            }
    }
};

struct EpiOut {
    static constexpr bool PERM = true;
    const float* x; bf16_t* out; unsigned char* h8; const LAS f32x2* tab;
    __device__ __forceinline__ void hook(f32x4 (&acc)[2][2][4][2], const Unit& u, int wr, int wc, int fr, int fq) const {
        const LAS f32x2* tp = tab + u.idx * BM + wr * 64 + fr;
#pragma unroll
        for (int ai = 0; ai < 2; ++ai)
#pragma unroll
            for (int m = 0; m < 4; ++m) { const float f = tp[ai * HALF + m * 16].x;
#pragma unroll
                for (int bj = 0; bj < 2; ++bj)
#pragma unroll
                    for (int n = 0; n < 2; ++n) acc[ai][bj][m][n] = acc[ai][bj][m][n] * f; }
    }
    __device__ __forceinline__ void operator()(f32x4 (&acc)[2][2][4][2], const Unit& u, int wr, int wc, int fr, int fq) const {
        const int row0 = u.pm * BM + wr * 64 + fr, col0 = u.pn * BM + wc * 32 + 8 * fq;
        const LAS f32x2* tp = tab + u.idx * BM + wr * 64 + fr;
#pragma unroll
        for (int ai = 0; ai < 2; ++ai)
#pragma unroll
            for (int mp = 0; mp < 2; ++mp) {
                f32x4 xv[2][2][2];
#pragma unroll
                for (int mm = 0; mm < 2; ++mm) { const size_t off = (size_t)(row0 + ai * HALF + (2 * mp + mm) * 16) * DM + col0;
#pragma unroll
                    for (int bj = 0; bj < 2; ++bj) { xv[mm][bj][0] = *(const GAS f32x4*)(x + off + bj * HALF); xv[mm][bj][1] = *(const GAS f32x4*)(x + off + bj * HALF + 4); } }
#pragma unroll
                for (int mm = 0; mm < 2; ++mm) { const int m = 2 * mp + mm; const float rs = tp[ai * HALF + m * 16].y;
                    const size_t off = (size_t)(row0 + ai * HALF + m * 16) * DM + col0;
#pragma unroll
                    for (int bj = 0; bj < 2; ++bj) {
                        const f32x4 h0 = xv[mm][bj][0] + acc[ai][bj][m][0] * rs, h1 = xv[mm][bj][1] + acc[ai][bj][m][1] * rs;
                        *(GAS u32x4*)(out + off + bj * HALF) = (u32x4){cvt_pk_bf16(h0[0], h0[1]), cvt_pk_bf16(h0[2], h0[3]), cvt_pk_bf16(h1[0], h1[1]), cvt_pk_bf16(h1[2], h1[3])};
                        int w0 = __builtin_amdgcn_cvt_pk_fp8_f32(h0[0], h0[1], 0, false); w0 = __builtin_amdgcn_cvt_pk_fp8_f32(h0[2], h0[3], w0, true);
                        int w1 = __builtin_amdgcn_cvt_pk_fp8_f32(h1[0], h1[1], 0, false); w1 = __builtin_amdgcn_cvt_pk_fp8_f32(h1[2], h1[3], w1, true);
                        *(GAS u32x2*)(h8 + off + bj * HALF) = (u32x2){(unsigned)w0, (unsigned)w1};
                    } }
            }
    }
};
template <class Sched>
__device__ __forceinline__ void p3_rowtab(LAS f32x2* tab, const Sched& S, const float* ass, const float* sss, int maxu) {
    Unit u;
    for (int i = 0; i < maxu && S.next(i, u); ++i) {
        if (threadIdx.x < BM) {
            const int row = u.pm * BM + threadIdx.x;
            const GAS f32x4* ap = (const GAS f32x4*)(ass + (size_t)row * 16); const GAS f32x4* sp = (const GAS f32x4*)(sss + (size_t)row * 32);
            const f32x4 sa = (ap[0] + ap[1]) + (ap[2] + ap[3]);
            const f32x4 s1 = (sp[0] + sp[1]) + (sp[2] + sp[3]), s2 = (sp[4] + sp[5]) + (sp[6] + sp[7]);
            const float A = (sa[0] + sa[1]) + (sa[2] + sa[3]), Sx = ((s1[0] + s1[1]) + (s1[2] + s1[3])) + ((s2[0] + s2[1]) + (s2[2] + s2[3]));
            const float ra = rsqrtf(A * (1.f / 1024.f) + EPS), rs = rsqrtf(Sx * (1.f / 1024.f) + EPS);
            tab[i * BM + threadIdx.x] = (f32x2){ra / rs, rs};
        }
    }
    __syncthreads();
}
}
__device__ __forceinline__ void p0_transpose_item(const float* W, int K, int N, bf16_t* WT, const float* gk, LAS float* scr, int item, int lane) {
    const int nblk = N / 64, kb = item / nblk, nb = item % nblk, k0 = 64 * kb, n0 = 64 * nb;
    const int lr = lane >> 4, lc = (lane & 15) * 4;
    f32x4 v[16];
    const float* src = W + (size_t)(k0 + lr) * N + n0 + lc;
#pragma unroll
    for (int i = 0; i < 16; ++i) v[i] = *(const GAS f32x4*)(src + (size_t)(4 * i) * N);
    if (gk) {
#pragma unroll
        for (int i = 0; i < 16; ++i) { const float g = gk[k0 + 4 * i + lr]; v[i] = v[i] * g; }
    }
#pragma unroll
    for (int i = 0; i < 16; ++i) { LAS float* d = scr + (4 * i + lr) * 65 + lc; d[0] = v[i].x; d[1] = v[i].y; d[2] = v[i].z; d[3] = v[i].w; }
    LDS_WAIT(); asm volatile("" ::: "memory");
    const int c = lane & 7;
#pragma unroll
    for (int j = 0; j < 8; ++j) { const int n = (lane >> 3) + 8 * j; const LAS float* s = scr + (8 * c) * 65 + n;
        u32x4 o; o.x = cvt_pk_bf16(s[0 * 65], s[1 * 65]); o.y = cvt_pk_bf16(s[2 * 65], s[3 * 65]); o.z = cvt_pk_bf16(s[4 * 65], s[5 * 65]); o.w = cvt_pk_bf16(s[6 * 65], s[7 * 65]);
        *(GAS u32x4*)(WT + (size_t)(n0 + n) * K + k0 + 8 * c) = o; }
    LDS_WAIT(); asm volatile("" ::: "memory");
}

constexpr int MOE_ITEMS_GU = (DM / 128) * (2 * DFF / 32), MOE_ITEMS_DN = (DFF / 128) * (DM / 32), MOE_ITEMS_E = MOE_ITEMS_GU + MOE_ITEMS_DN;
struct TrItem { const float* W; unsigned char* WT; const float* gk; int K, N, k0, n0, sw; };
__device__ __forceinline__ TrItem moe_item(const Args& a, int it) {
    TrItem t; const int e = it / MOE_ITEMS_E, q = it % MOE_ITEMS_E;
    if (q < MOE_ITEMS_GU) { t.W = a.in[17] + (size_t)e * DM * 2 * DFF; t.WT = a.ws + WS_WGU + (size_t)e * 2 * DFF * DM; t.gk = a.in[14]; t.sw = 1; t.K = DM; t.N = 2 * DFF; const int nblk = 2 * DFF / 32; t.k0 = 128 * (q / nblk); t.n0 = 32 * (q % nblk); }
    else { const int r = q - MOE_ITEMS_GU; t.W = a.in[19] + (size_t)e * DFF * DM; t.WT = a.ws + WS_WDN + (size_t)e * DM * DFF; t.gk = nullptr; t.sw = 0; t.K = DFF; t.N = DM; const int nblk = DM / 32; t.k0 = 128 * (r / nblk); t.n0 = 32 * (r % nblk); }
    return t;
}
__device__ __forceinline__ void tr8_load(const TrItem& t, int lane, f32x4 (&v)[16]) {
    const int lr = lane >> 3, lc = (lane & 7) * 4;
    const float* src = t.W + (size_t)(t.k0 + lr) * t.N + t.n0 + lc;
#pragma unroll
    for (int i = 0; i < 16; ++i) v[i] = __builtin_nontemporal_load((const f32x4*)(src + (size_t)(8 * i) * t.N));
}
__device__ __forceinline__ void tr8_store(const TrItem& t, int lane, f32x4 (&v)[16], LAS float* scr, const float (&gs)[8]) {
    const int lr = lane >> 3, lc = (lane & 7) * 4;
#pragma unroll
    for (int i = 0; i < 16; ++i) { LAS float* d = scr + (8 * i + lr) * 33 + lc; d[0] = v[i].x; d[1] = v[i].y; d[2] = v[i].z; d[3] = v[i].w; }
    LDS_WAIT(); asm volatile("" ::: "memory");
    const int c = lane >> 2, nl = lane & 3, no = t.sw ? (nl ^ (((nl ^ (nl >> 1)) & 1) * 3)) : nl;
#pragma unroll
    for (int j = 0; j < 8; ++j) { const int n = nl + 4 * j; const LAS float* s = scr + (8 * c) * 33 + n;
        int w0 = __builtin_amdgcn_cvt_pk_fp8_f32(s[0 * 33] * gs[0], s[1 * 33] * gs[1], 0, false); w0 = __builtin_amdgcn_cvt_pk_fp8_f32(s[2 * 33] * gs[2], s[3 * 33] * gs[3], w0, true);
        int w1 = __builtin_amdgcn_cvt_pk_fp8_f32(s[4 * 33] * gs[4], s[5 * 33] * gs[5], 0, false); w1 = __builtin_amdgcn_cvt_pk_fp8_f32(s[6 * 33] * gs[6], s[7 * 33] * gs[7], w1, true);
        __builtin_nontemporal_store((u32x2){(unsigned)w0, (unsigned)w1}, (u32x2*)(t.WT + (size_t)(t.n0 + 4 * j + no) * t.K + t.k0 + 8 * c)); }
    LDS_WAIT(); asm volatile("" ::: "memory");
}
constexpr int MOE_NCHUNK = NE * MOE_ITEMS_E / 32;
__device__ __forceinline__ void moe_convert_chunk(Frame& F, const Args& a, int c) {
    LAS float* scr = (LAS float*)(F.lds + F.wave * 16896);
    const int i0 = c * 32 + F.wave * 4;
    const TrItem t0 = moe_item(a, i0);
    TrItem t1 = t0, t2 = t0, t3 = t0; t1.n0 += 32; t2.n0 += 64; t3.n0 += 96;
    f32x4 v0[16], v1[16];
    tr8_load(t0, F.lane, v0); tr8_load(t1, F.lane, v1);
    float gs[8];
    if (t0.gk) { const f32x4 g0 = *(const GAS f32x4*)(t0.gk + t0.k0 + 8 * (F.lane >> 2)), g1 = *(const GAS f32x4*)(t0.gk + t0.k0 + 8 * (F.lane >> 2) + 4);
#pragma unroll
        for (int q = 0; q < 4; ++q) { gs[q] = g0[q] * 64.f; gs[4 + q] = g1[q] * 64.f; } }
    else {
#pragma unroll
        for (int q = 0; q < 8; ++q) gs[q] = 64.f; }
    tr8_store(t0, F.lane, v0, scr, gs); tr8_load(t2, F.lane, v0);
    tr8_store(t1, F.lane, v1, scr, gs); tr8_load(t3, F.lane, v1);
    tr8_store(t2, F.lane, v0, scr, gs);
    tr8_store(t3, F.lane, v1, scr, gs);
}
__device__ __forceinline__ void moe_convert_pull(Frame& F, const Args& a, int maxn = 0x7fffffff) {
    volatile LAS int* slot = (volatile LAS int*)(F.MISC + 16);
    unsigned* qh = F.ctl + CW_QHEAD;
    __syncthreads(); if (F.tid == 0) slot[0] = (int)xb_add(qh, 1u); __syncthreads();
    int pend = slot[0], done = 0;
    while (pend < MOE_NCHUNK) {
        __syncthreads();
        unsigned nb = (unsigned)MOE_NCHUNK;
        if (F.tid == 0 && ++done < maxn) nb = xb_add(qh, 1u);
        moe_convert_chunk(F, a, pend);
        if (F.tid == 0) slot[0] = (int)nb;
        __syncthreads();
        pend = slot[0];
    }
}

__device__ __forceinline__ void p0_prologue(Frame& F, const Args& a) {
    unsigned char* ws = a.ws;
    LAS float* scr = (LAS float*)(F.lds + F.wave * 16896);
    const int gw = F.vcu * NWAVES + F.wave, NGW = F.G * NWAVES;
    constexpr int I_IN = (DM / 64) * (DIN / 64), I_OUT = (DM / 64) * (DM / 64), I_PG = I_OUT, I_PLE = (DPLE / 64) * (DM / 64);
    const int NITEMS = I_IN + I_OUT + I_PG + I_PLE;
    for (int it = gw; it < NITEMS; it += NGW) {
        int r = it;
        if (r < I_IN) { p0_transpose_item(a.in[3], DM, DIN, (bf16_t*)(ws + WS_WIN), a.in[2], scr, r, F.lane); continue; } r -= I_IN;
        if (r < I_OUT) { const int kb = r / (DM / 64); p0_transpose_item(a.in[13], DM, DM, (bf16_t*)(ws + WS_WOUT), kb < 16 ? a.in[11] : a.in[12] - DATT, scr, r, F.lane); continue; } r -= I_OUT;
        if (r < I_PG) {
            TrItem t; t.W = a.in[23]; t.WT = ws + WS_WPG; t.gk = a.in[22]; t.sw = 0; t.K = DM; t.N = DM; t.k0 = 128 * (r / (DM / 32)); t.n0 = 32 * (r % (DM / 32));
            f32x4 v[16]; tr8_load(t, F.lane, v);
            const f32x4 g0 = *(const GAS f32x4*)(t.gk + t.k0 + 8 * (F.lane >> 2)), g1 = *(const GAS f32x4*)(t.gk + t.k0 + 8 * (F.lane >> 2) + 4);
            float gs[8];
#pragma unroll
            for (int q = 0; q < 4; ++q) { gs[q] = g0[q] * 64.f; gs[4 + q] = g1[q] * 64.f; }
            tr8_store(t, F.lane, v, scr, gs); continue; } r -= I_PG;
        p0_transpose_item(a.in[21], DPLE, DM, (bf16_t*)(ws + WS_WPLE), nullptr, scr, r, F.lane);
    }
    const float* x = a.in[0];
    for (int m = gw; m < T; m += NGW) {
        const GAS f32x4* xr = (const GAS f32x4*)(x + (size_t)m * DM) + F.lane;
        f32x4 v[8]; float s = 0.f;
#pragma unroll
        for (int j = 0; j < 8; ++j) { v[j] = __builtin_nontemporal_load((const f32x4*)(x + (size_t)m * DM) + 64 * j + F.lane); s += (v[j].x * v[j].x + v[j].y * v[j].y) + (v[j].z * v[j].z + v[j].w * v[j].w); }
        const float rs = rsqrtf(wave_sum(s) * (1.f / DM) + EPS);
        GAS u32x2* o = (GAS u32x2*)((bf16_t*)(ws + WS_XB) + (size_t)m * DM) + F.lane;
#pragma unroll
        for (int j = 0; j < 8; ++j) o[64 * j] = (u32x2){cvt_pk_bf16(v[j].x * rs, v[j].y * rs), cvt_pk_bf16(v[j].z * rs, v[j].w * rs)};
    }
    {
        const GAS f32x4* pr = (const GAS f32x4*)a.in[1]; GAS u32x2* po = (GAS u32x2*)(ws + WS_PB);
        for (int i = (F.vcu * NWAVES * 64) + F.tid; i < T * DPLE / 4; i += F.G * NWAVES * 64) { const f32x4 v = pr[i]; po[i] = (u32x2){cvt_pk_bf16(v.x, v.y), cvt_pk_bf16(v.z, v.w)}; }
    }
    {
        const float* wsrc = a.in[9]; bf16_t* wd = (bf16_t*)(ws + WS_WSP);
        for (int i = (F.vcu * NWAVES * 64) + F.tid; i < NSG * SGC * SGC / 2; i += F.G * NWAVES * 64) {
            const int e0 = 2 * i, t = (e0 >> 7) & 127, s0 = e0 & 127;
            const float a0 = (s0 <= t) ? wsrc[e0] : 0.f, a1 = (s0 + 1 <= t) ? wsrc[e0 + 1] : 0.f;
            ((unsigned*)wd)[i] = cvt_pk_bf16(a0, a1); }
        const float* wr = a.in[15]; const float* g2 = a.in[14]; float* wo = (float*)(ws + WS_WR);
        for (int i = (F.vcu * NWAVES * 64) + F.tid; i < DM * NE; i += F.G * NWAVES * 64) wo[i] = wr[i] * g2[i >> 5];
    }
}
typedef short v4i16_t __attribute__((ext_vector_type(4)));
typedef short s16x4 __attribute__((ext_vector_type(4)));
__device__ __forceinline__ s16x4 ds_tr16(LAS const unsigned char* p) { return __builtin_bit_cast(s16x4, __builtin_amdgcn_ds_read_tr16_b64_v4i16((LAS v4i16_t*)p)); }
__device__ __forceinline__ bf16x8 cat48(s16x4 a, s16x4 b) { bf16x8 r; r[0] = a[0]; r[1] = a[1]; r[2] = a[2]; r[3] = a[3]; r[4] = b[0]; r[5] = b[1]; r[6] = b[2]; r[7] = b[3]; return r; }
__device__ __forceinline__ bf16x8 pack8(float a0, float a1, float a2, float a3, float a4, float a5, float a6, float a7) {
    u32x4 w; w.x = cvt_pk_bf16(a0, a1); w.y = cvt_pk_bf16(a2, a3); w.z = cvt_pk_bf16(a4, a5); w.w = cvt_pk_bf16(a6, a7); return __builtin_bit_cast(bf16x8, w); }

constexpr float LOG2E = 1.4426950408889634f;
constexpr int ATT_K_OFF = 0, ATT_V_OFF = 32768;
__device__ __forceinline__ int k_img(int row, int ch) { return row * 128 + ((ch ^ (row & 7)) << 4); }
__device__ __forceinline__ int v_img(int row, int ch) { return row * 128 + ((ch ^ (((row >> 1) & 1) << 2)) << 4); }
__device__ __forceinline__ int sv_img(int row, int ch) { return row * 256 + ((ch ^ ((row & 3) << 2)) << 4); }

__device__ __forceinline__ void attn_unit(Frame& F, const Args& a, int unit) {
    unsigned char* ws = a.ws;
    const bf16_t* proj = (const bf16_t*)(ws + WS_PROJ);
    const int n = unit >> 2, kvh = unit & 3;
    LAS unsigned char* lds = F.lds;
    __syncthreads();
    {
        const int row = F.tid >> 1, half = F.tid & 1;
        const int kabs = (n - 1) * 128 + row;
        u32x4 kv[4], vv[4];
        if (kabs >= 0) {
            const GAS u32x4* kp = (const GAS u32x4*)(proj + (size_t)kabs * DIN + KOFF + kvh * 64 + half * 32);
            const GAS u32x4* vp = (const GAS u32x4*)(proj + (size_t)kabs * DIN + VOFF + kvh * 64 + half * 32);
#pragma unroll
            for (int j = 0; j < 4; ++j) { kv[j] = kp[j]; vv[j] = vp[j]; }
        } else {
#pragma unroll
            for (int j = 0; j < 4; ++j) { kv[j] = (u32x4){0u, 0u, 0u, 0u}; vv[j] = (u32x4){0u, 0u, 0u, 0u}; }
        }
        float ss = 0.f;
#pragma unroll
        for (int j = 0; j < 4; ++j)
#pragma unroll
            for (int e = 0; e < 4; ++e) { const float lo = bflo(kv[j][e]), hi = bfhi(kv[j][e]); ss += lo * lo + hi * hi; }
        ss += __shfl_xor(ss, 1);
        const float rs = rsqrtf(ss * (1.f / 64.f) + EPS);
        const float* kg = a.in[5] + half * 32;
#pragma unroll
        for (int j = 0; j < 4; ++j) {
            u32x4 w;
#pragma unroll
            for (int e = 0; e < 4; ++e) w[e] = cvt_pk_bf16(bflo(kv[j][e]) * rs * kg[j * 8 + 2 * e], bfhi(kv[j][e]) * rs * kg[j * 8 + 2 * e + 1]);
            *(LAS u32x4*)(lds + ATT_K_OFF + k_img(row, half * 4 + j)) = w;
            *(LAS u32x4*)(lds + ATT_V_OFF + v_img(row, half * 4 + j)) = vv[j];
        }
    }
    __syncthreads();
    const int g = F.wave >> 1, h = kvh * 4 + g, l31 = F.lane & 31, hh = F.lane >> 5;
    const float sink2 = a.in[6][h] * LOG2E;
    const float* qg = a.in[4];
    bf16_t* mg = (bf16_t*)(ws + WS_MG);
    float* ass = (float*)(ws + WS_ASS);
#pragma unroll 1
    for (int qb = 0; qb < 2; ++qb) {
        const int r0 = (F.wave & 1) * 64 + qb * 32, qi = r0 + l31, qabs = n * 128 + qi;
        bf16x8 qf[4];
        {
            const GAS u32x4* qp = (const GAS u32x4*)(proj + (size_t)qabs * DIN + QOFF + h * 64 + 8 * hh);
            u32x4 qv[4]; float ss = 0.f;
#pragma unroll
            for (int s = 0; s < 4; ++s) { qv[s] = qp[2 * s];
#pragma unroll
                for (int e = 0; e < 4; ++e) { const float lo = bflo(qv[s][e]), hi = bfhi(qv[s][e]); ss += lo * lo + hi * hi; } }
            ss += __shfl_xor(ss, 32);
            const float rs = rsqrtf(ss * (1.f / 64.f) + EPS) * (0.125f * LOG2E);
#pragma unroll
            for (int s = 0; s < 4; ++s) { u32x4 w;
#pragma unroll
                for (int e = 0; e < 4; ++e) { const int d = 16 * s + 8 * hh + 2 * e; w[e] = cvt_pk_bf16(bflo(qv[s][e]) * rs * qg[d], bfhi(qv[s][e]) * rs * qg[d + 1]); }
                qf[s] = __builtin_bit_cast(bf16x8, w); }
        }
        const int kb0 = r0 >> 5;
        f32x16 st[5];
#pragma unroll
        for (int j = 0; j < 5; ++j) {
            st[j] = (f32x16){0.f, 0.f, 0.f, 0.f, 0.f, 0.f, 0.f, 0.f, 0.f, 0.f, 0.f, 0.f, 0.f, 0.f, 0.f, 0.f};
            const int krow = 32 * (kb0 + j) + l31;
#pragma unroll
            for (int s = 0; s < 4; ++s) {
                const bf16x8 kf = *(const LAS bf16x8*)(lds + ATT_K_OFF + k_img(krow, 2 * s + hh));
                st[j] = __builtin_amdgcn_mfma_f32_32x32x16_bf16(kf, qf[s], st[j], 0, 0, 0);
            }
        }
        const int lo = (n == 0) ? 128 : qi + 1, hi = qi + 128;
        float m = sink2;
#pragma unroll
        for (int j = 0; j < 5; ++j)
#pragma unroll
            for (int r = 0; r < 16; ++r) { const int sj = 32 * (kb0 + j) + (r & 3) + 8 * (r >> 2) + 4 * hh; const bool ok = (sj >= lo) && (sj <= hi);
                st[j][r] = ok ? st[j][r] : -3.0e38f; m = fmaxf(m, st[j][r]); }
        m = fmaxf(m, __shfl_xor(m, 32));
        float lsum = 0.f;
#pragma unroll
        for (int j = 0; j < 5; ++j)
#pragma unroll
            for (int r = 0; r < 16; ++r) { const float p = __builtin_amdgcn_exp2f(st[j][r] - m); st[j][r] = p; lsum += p; }
        lsum += __shfl_xor(lsum, 32);
        lsum += __builtin_amdgcn_exp2f(sink2 - m);
        const float inv = 1.f / lsum;
        f32x16 o[2];
        o[0] = (f32x16){0.f, 0.f, 0.f, 0.f, 0.f, 0.f, 0.f, 0.f, 0.f, 0.f, 0.f, 0.f, 0.f, 0.f, 0.f, 0.f}; o[1] = o[0];
        const int li = F.lane & 15, lg = (F.lane >> 4) & 1;
#pragma unroll
        for (int j = 0; j < 5; ++j)
#pragma unroll
            for (int s = 0; s < 2; ++s) {
                const bf16x8 pf = pack8(st[j][8 * s + 0], st[j][8 * s + 1], st[j][8 * s + 2], st[j][8 * s + 3], st[j][8 * s + 4], st[j][8 * s + 5], st[j][8 * s + 6], st[j][8 * s + 7]);
                const int kbase = 32 * (kb0 + j) + 16 * s + 4 * hh + (li >> 2);
#pragma unroll
                for (int db = 0; db < 2; ++db) {
                    const int col = 32 * db + 16 * lg + 4 * (li & 3);
                    const s16x4 v0 = ds_tr16(lds + ATT_V_OFF + v_img(kbase, col >> 3) + (col & 7) * 2);
                    const s16x4 v1 = ds_tr16(lds + ATT_V_OFF + v_img(kbase + 8, col >> 3) + (col & 7) * 2);
                    o[db] = __builtin_amdgcn_mfma_f32_32x32x16_bf16(cat48(v0, v1), pf, o[db], 0, 0, 0);
                }
            }
        float ssq = 0.f;
        bf16_t* orow = mg + (size_t)qabs * DM + h * 64 + 4 * hh;
#pragma unroll
        for (int db = 0; db < 2; ++db)
#pragma unroll
            for (int rq = 0; rq < 4; ++rq) {
                u32x2 w; w.x = cvt_pk_bf16(o[db][4 * rq] * inv, o[db][4 * rq + 1] * inv); w.y = cvt_pk_bf16(o[db][4 * rq + 2] * inv, o[db][4 * rq + 3] * inv);
                *(GAS u32x2*)(orow + 32 * db + 8 * rq) = w;
                const float e0 = bflo(w.x), e1 = bfhi(w.x), e2 = bflo(w.y), e3 = bfhi(w.y);
                ssq += (e0 * e0 + e1 * e1) + (e2 * e2 + e3 * e3);
            }
        ssq += __shfl_xor(ssq, 32);
        if (hh == 0) ass[(size_t)qabs * 16 + h] = ssq;
    }
}

struct SgStage { u32x4 v[4]; f32x2 st[4]; };
__device__ __forceinline__ void sg_prefetch(Frame& F, const Args& a, int unit, SgStage& S) {
    unsigned char* ws = a.ws;
    const bf16_t* proj = (const bf16_t*)(ws + WS_PROJ);
    const int nc = unit >> 3, g = unit & 7, s = F.tid >> 2, qt = F.tid & 3;
    const size_t row = (size_t)nc * 128 + s;
    const GAS f32x2* sp = (const GAS f32x2*)(ws + WS_STATS) + row * 16 + qt * 4;
    const GAS u32x4* vp = (const GAS u32x4*)(proj + row * DIN + GOFF + g * 128 + qt * 32);
#pragma unroll
    for (int j = 0; j < 4; ++j) { S.st[j] = sp[j]; S.v[j] = vp[j]; }
}
__device__ __forceinline__ void sg_unit(Frame& F, const Args& a, int unit, SgStage& S, int next_unit) {
    unsigned char* ws = a.ws;
    const bf16_t* proj = (const bf16_t*)(ws + WS_PROJ);
    const int nc = unit >> 3, g = unit & 7;
    LAS unsigned char* lds = F.lds;
    f32x4 gl[8], bl[8];
    { const int qt0 = F.tid & 3; const GAS f32x4* lgp0 = (const GAS f32x4*)(a.in[7] + g * 128 + qt0 * 32); const GAS f32x4* lbp0 = (const GAS f32x4*)(a.in[8] + g * 128 + qt0 * 32);
#pragma unroll
      for (int j = 0; j < 8; ++j) { gl[j] = lgp0[j]; bl[j] = lbp0[j]; } }
    __syncthreads();
    {
        const int s = F.tid >> 2, qt = F.tid & 3;
        float Sx = 0.f, SS = 0.f;
#pragma unroll
        for (int j = 0; j < 4; ++j) { Sx += S.st[j].x; SS += S.st[j].y; }
        Sx += __shfl_xor(Sx, 1); SS += __shfl_xor(SS, 1); Sx += __shfl_xor(Sx, 2); SS += __shfl_xor(SS, 2);
        const float mu = Sx * (1.f / 1024.f), var = SS * (1.f / 1024.f) - mu * mu, rs = rsqrtf(fmaxf(var, 0.f) + EPS);
#pragma unroll
        for (int j = 0; j < 4; ++j) { const u32x4 v = S.v[j]; const f32x4 g0 = gl[2 * j], g1 = gl[2 * j + 1], b0 = bl[2 * j], b1 = bl[2 * j + 1]; u32x4 w;
            w.x = cvt_pk_bf16((bflo(v.x) - mu) * rs * g0[0] + b0[0], (bfhi(v.x) - mu) * rs * g0[1] + b0[1]);
            w.y = cvt_pk_bf16((bflo(v.y) - mu) * rs * g0[2] + b0[2], (bfhi(v.y) - mu) * rs * g0[3] + b0[3]);
            w.z = cvt_pk_bf16((bflo(v.z) - mu) * rs * g1[0] + b1[0], (bfhi(v.z) - mu) * rs * g1[1] + b1[1]);
            w.w = cvt_pk_bf16((bflo(v.w) - mu) * rs * g1[2] + b1[2], (bfhi(v.w) - mu) * rs * g1[3] + b1[3]);
            *(LAS u32x4*)(lds + sv_img(s, qt * 4 + j)) = w; }
    }
    if (next_unit >= 0) sg_prefetch(F, a, next_unit, S);
    __syncthreads();
    const int cb = F.wave & 3, l31 = F.lane & 31, hh = F.lane >> 5, li = F.lane & 15, lg = (F.lane >> 4) & 1;
    const bf16_t* wsp = (const bf16_t*)(ws + WS_WSP) + (size_t)g * 128 * 128;
    const float* bsp = a.in[10] + g * 128;
    bf16_t* mg = (bf16_t*)(ws + WS_MG);
    float* sss = (float*)(ws + WS_SSS);
    const int col = 32 * cb + 16 * lg + 4 * (li & 3);
    bf16x8 wf[2][8]; u32x2 uvv[2][4]; float btv[2];
#pragma unroll
    for (int ti = 0; ti < 2; ++ti) { const int t = 32 * (2 * (F.wave >> 2) + ti) + l31; const size_t tabs = (size_t)nc * 128 + t;
#pragma unroll
        for (int ks = 0; ks < 8; ++ks) wf[ti][ks] = *(const GAS bf16x8*)(wsp + (size_t)t * 128 + 16 * ks + 8 * hh);
#pragma unroll
        for (int rq = 0; rq < 4; ++rq) uvv[ti][rq] = *(const GAS u32x2*)(proj + tabs * DIN + UOFF + g * 128 + 32 * cb + 4 * hh + 8 * rq);
        btv[ti] = bsp[t]; }
#pragma unroll
    for (int ti = 0; ti < 2; ++ti) {
        const int tb = 2 * (F.wave >> 2) + ti, t = 32 * tb + l31;
        f32x16 acc = (f32x16){0.f, 0.f, 0.f, 0.f, 0.f, 0.f, 0.f, 0.f, 0.f, 0.f, 0.f, 0.f, 0.f, 0.f, 0.f, 0.f};
        const int nks = 2 * tb + 2;
#pragma unroll
        for (int ks = 0; ks < 8; ++ks) {
            if (ks < nks) {
                const int kbase = 16 * ks + 8 * hh + (li >> 2);
                const s16x4 v0 = ds_tr16(lds + sv_img(kbase, col >> 3) + (col & 7) * 2);
                const s16x4 v1 = ds_tr16(lds + sv_img(kbase + 4, col >> 3) + (col & 7) * 2);
                acc = __builtin_amdgcn_mfma_f32_32x32x16_bf16(cat48(v0, v1), wf[ti][ks], acc, 0, 0, 0);
            }
        }
        const size_t tabs = (size_t)nc * 128 + t;
        const float bt = btv[ti];
        bf16_t* orow = mg + tabs * DM + DATT + g * 128 + 32 * cb + 4 * hh;
        float ssq = 0.f;
#pragma unroll
        for (int rq = 0; rq < 4; ++rq) {
            const u32x2 uv = uvv[ti][rq];
            u32x2 w; w.x = cvt_pk_bf16(bflo(uv.x) * (acc[4 * rq] + bt), bfhi(uv.x) * (acc[4 * rq + 1] + bt)); w.y = cvt_pk_bf16(bflo(uv.y) * (acc[4 * rq + 2] + bt), bfhi(uv.y) * (acc[4 * rq + 3] + bt));
            *(GAS u32x2*)(orow + 8 * rq) = w;
            const float e0 = bflo(w.x), e1 = bfhi(w.x), e2 = bflo(w.y), e3 = bfhi(w.y);
            ssq += (e0 * e0 + e1 * e1) + (e2 * e2 + e3 * e3);
        }
        ssq += __shfl_xor(ssq, 32);
        if (hh == 0) sss[tabs * 32 + g * 4 + cb] = ssq;
    }
}

__device__ __forceinline__ void p2_mixers(Frame& F, const Args& a) {
    for (int u = F.cvcu; u < (T / 128) * NKVH; u += F.cG) attn_unit(F, a, u);
    {
        SgStage S; const int nsg = (T / 128) * NSG, nat = (T / 128) * NKVH;
        const bool bal = (F.cG == 152 && nsg == 512 && nat == 256);
        const int r1 = F.cvcu - (nat - F.cG);
        auto unit_at = [&](int k) -> int {
            if (!bal) { const int u = F.cvcu + k * F.cG; return u < nsg ? u : -1; }
            if (k < 3) return F.cvcu + k * F.cG;
            if (r1 < 0) return -1;
            if (k == 3) return 3 * F.cG + r1;
            if (k == 4 && r1 < nsg - 3 * F.cG - (2 * F.cG - nat)) return 3 * F.cG + (2 * F.cG - nat) + r1;
            return -1; };
        int u = unit_at(0);
        if (u >= 0) sg_prefetch(F, a, u, S);
        for (int k = 0; u >= 0; ++k) { const int nx = unit_at(k + 1); sg_unit(F, a, u, S, nx); u = nx; }
    }
}
constexpr int RT_W = 0, RT_H = 65536;
__device__ __forceinline__ void p4_router(Frame& F, const Args& a) {
    unsigned char* ws = a.ws;
    const bf16_t* h = (const bf16_t*)(ws + WS_HF);
    const float* wr = (const float*)(ws + WS_WR);
    const float* br = a.in[16];
    int* cnt = (int*)(F.ctl + CW_CNT);
    int* row_tok = (int*)(ws + WS_ROWTOK); float* row_rs = (float*)(ws + WS_ROWRS);
    int* tokinfo = (int*)(ws + WS_TOKINFO); float* tokgate = (float*)(ws + WS_TOKINFO + 131072);
    const int eg = F.lane & 7, kq = F.lane >> 3;
    for (int grp = F.cvcu; grp < T / 32; grp += F.cG) {
        const int tok0 = grp * 32 + F.wave * 4;
        f32x4 acc[4]; float ssq[4] = {0.f, 0.f, 0.f, 0.f};
#pragma unroll
        for (int t = 0; t < 4; ++t) acc[t] = (f32x4){0.f, 0.f, 0.f, 0.f};
        f32x4 wv[4], hv4[4]; u32x2 hr[4];
        const GAS f32x4* wsrc = (const GAS f32x4*)wr + F.tid;
        const GAS u32x2* hsrc = (const GAS u32x2*)(h + (size_t)tok0 * DM) + F.lane;
        __syncthreads();
#pragma unroll
        for (int i = 0; i < 4; ++i) { wv[i] = wsrc[i * 512]; hr[i] = hsrc[(size_t)i * (DM / 4)]; }
#pragma unroll 1
        for (int c = 0; c < 8; ++c) {
            LAS f32x4* Wl = (LAS f32x4*)(F.lds + RT_W + (c & 1) * 32768);
            LAS f32x4* hs = (LAS f32x4*)(F.lds + RT_H + (c & 1) * 32768 + F.wave * 4096);
#pragma unroll
            for (int i = 0; i < 4; ++i) Wl[F.tid + i * 512] = wv[i];
#pragma unroll
            for (int t = 0; t < 4; ++t) hv4[t] = (f32x4){bflo(hr[t].x), bfhi(hr[t].x), bflo(hr[t].y), bfhi(hr[t].y)};
#pragma unroll
            for (int t = 0; t < 4; ++t) ssq[t] += (hv4[t].x * hv4[t].x + hv4[t].y * hv4[t].y) + (hv4[t].z * hv4[t].z + hv4[t].w * hv4[t].w);
#pragma unroll
            for (int cc = 0; cc < 4; ++cc) hs[4 * F.lane + cc] = (f32x4){hv4[0][cc], hv4[1][cc], hv4[2][cc], hv4[3][cc]};
            if (c < 7) {
#pragma unroll
                for (int i = 0; i < 4; ++i) { wv[i] = wsrc[(c + 1) * 2048 + i * 512]; hr[i] = hsrc[(size_t)i * (DM / 4) + (c + 1) * 64]; }
            }
            __syncthreads();
            f32x4 w[2][8], hv[2][8];
#pragma unroll
            for (int q = 0; q < 8; ++q) { w[0][q] = Wl[(8 * q + kq) * 8 + eg]; hv[0][q] = hs[8 * q + kq]; }
#pragma unroll
            for (int b = 0; b < 4; ++b) {
                if (b < 3) {
#pragma unroll
                    for (int q = 0; q < 8; ++q) { w[(b + 1) & 1][q] = Wl[(8 * (8 * (b + 1) + q) + kq) * 8 + eg]; hv[(b + 1) & 1][q] = hs[8 * (8 * (b + 1) + q) + kq]; }
                }
#pragma unroll
                for (int q = 0; q < 8; ++q)
#pragma unroll
                    for (int t = 0; t < 4; ++t) acc[t] = acc[t] + w[b & 1][q] * hv[b & 1][q][t];
            }
        }
        const f32x4 be = *(const GAS f32x4*)(br + 4 * eg);
        f32x4 cand[4];
#pragma unroll
        for (int t = 0; t < 4; ++t) { const float rs = rsqrtf(wave_sum(ssq[t]) * (1.f / DM) + EPS); ssq[t] = rs;
#pragma unroll
            for (int i = 0; i < 4; ++i) { float s = acc[t][i]; s += __shfl_xor(s, 8); s += __shfl_xor(s, 16); s += __shfl_xor(s, 32); cand[t][i] = s * rs + be[i]; } }
        int sel_e[4][4]; float sel_v[4][4];
#pragma unroll
        for (int t = 0; t < 4; ++t) {
#pragma unroll
            for (int k = 0; k < 4; ++k) {
                float bv = cand[t][0]; int bi = 4 * eg;
#pragma unroll
                for (int i = 1; i < 4; ++i) if (cand[t][i] > bv) { bv = cand[t][i]; bi = 4 * eg + i; }
#pragma unroll
                for (int o = 1; o < 8; o <<= 1) { const float ov = __shfl_xor(bv, o); const int oi = __shfl_xor(bi, o); const bool take = (ov > bv) || (ov == bv && oi < bi); bv = take ? ov : bv; bi = take ? oi : bi; }
                sel_e[t][k] = bi; sel_v[t][k] = bv;
#pragma unroll
                for (int i = 0; i < 4; ++i) if (bi == 4 * eg + i) cand[t][i] = -3.0e38f;
            }
        }
        {
            LAS int* hist = (LAS int*)(F.lds + XTR_OFF);
            if (F.tid < 64) hist[F.tid] = 0;
            __syncthreads();
            const int ti = (F.lane >> 2) & 3, k = F.lane & 3;
            int me = 0; float mv = 0.f, v0 = 0.f, v1 = 0.f, v2 = 0.f, v3 = 0.f, rs = 0.f;
#pragma unroll
            for (int t = 0; t < 4; ++t) if (ti == t) { rs = ssq[t]; v0 = sel_v[t][0]; v1 = sel_v[t][1]; v2 = sel_v[t][2]; v3 = sel_v[t][3];
#pragma unroll
                for (int kk = 0; kk < 4; ++kk) if (k == kk) { me = sel_e[t][kk]; mv = sel_v[t][kk]; } }
            const float e0 = 1.f, e1 = __expf(v1 - v0), e2 = __expf(v2 - v0), e3 = __expf(v3 - v0);
            const float gate = __expf(mv - v0) / ((e0 + e1) + (e2 + e3));
            int rank = 0;
            if (F.lane < 16) rank = __hip_atomic_fetch_add(hist + me, 1, __ATOMIC_RELAXED, __HIP_MEMORY_SCOPE_WORKGROUP);
            __syncthreads();
            if (F.tid < NE) { const int c = hist[F.tid]; hist[32 + F.tid] = c ? atomicAdd(&cnt[64 * F.tid], c) : 0; }
            __syncthreads();
            if (F.lane < 16) {
                const int tok = tok0 + ti;
                const int pos = hist[32 + me] + rank;
                row_tok[me * CAP + pos] = tok; row_rs[me * CAP + pos] = rs;
                tokinfo[tok * 4 + k] = (me << 16) | pos; tokgate[tok * 4 + k] = gate;
            }
        }
    }
}

constexpr int MOE_MAXU = 12;
constexpr int XTR_GTAB = 0, XTR_ULIST = MOE_MAXU * 1024, XTR_ROWOFF = XTR_ULIST + 512;
struct MoeOrder {
    const char* A; const char* Bt; size_t estride; int rb; bool gather; const LAS int* ulist; const LAS unsigned* gtab; int nunits;
    __device__ __forceinline__ bool next(int i, pg8::Unit& u) const {
        if (i >= nunits) return false;
        const LAS int* p = ulist + 4 * i;
        u.e = __builtin_amdgcn_readfirstlane(p[0]); u.pm = __builtin_amdgcn_readfirstlane(p[1]); u.pn = __builtin_amdgcn_readfirstlane(p[2]); u.rows = __builtin_amdgcn_readfirstlane(p[3]); u.idx = i; return true;
    }
    __device__ __forceinline__ const char* a_ptr(const pg8::Unit& u) const { return gather ? A : A + (size_t)u.pm * ((size_t)pg8::HALF * rb); }
    __device__ __forceinline__ const char* b_ptr(const pg8::Unit& u) const { return Bt + (size_t)u.e * estride + (size_t)u.pn * ((size_t)pg8::BM * rb); }
    __device__ __forceinline__ unsigned gather_off(int ui, int r) const { return gtab[ui * 256 + r]; }
};
__device__ __forceinline__ int moe_build(Frame& F, const Args& a, int nN, bool gather) {
    unsigned char* ws = a.ws;
    const int* cnt = (const int*)(F.ctl + CW_CNT);
    LAS int* ulist = (LAS int*)(F.lds + XTR_OFF + XTR_ULIST);
    LAS int* rowoff = (LAS int*)(F.lds + XTR_OFF + XTR_ROWOFF);
    LAS unsigned* gtab = (LAS unsigned*)(F.lds + XTR_OFF + XTR_GTAB);
    LAS int* cl = (LAS int*)(F.lds + XTR_OFF + XTR_ROWOFF + 160);
    LAS int* nu = (LAS int*)(F.lds + XTR_OFF + XTR_ROWOFF + 320);
    __syncthreads();
    if (F.tid < NE) cl[F.tid] = __hip_atomic_load(cnt + 64 * F.tid, __ATOMIC_RELAXED, __HIP_MEMORY_SCOPE_AGENT);
    __syncthreads();
    if (F.tid < 64) {
        const int i = F.tid;
        const int c8 = (F.G % 8 == 0), per = c8 ? F.G / 8 : F.G, x = c8 ? (int)(blockIdx.x % 8) : 0, j = c8 ? (int)(blockIdx.x / 8) : (int)blockIdx.x;
        int U = 0;
#pragma unroll
        for (int e = 0; e < NE; ++e) U += ((cl[e] + 255) >> 8) * nN;
        const int Q = U / F.G, R = U - Q * F.G, s = x * per + j;
        const bool split = (2 * R <= F.G);
        int L = (i * 8 + x) * per + j, half = -1;
        if (!c8) L = i * F.G + j;
        if (i == Q && split) { L = Q * F.G + (s >> 1); half = s & 1; if (s >= 2 * R) L = U; }
        if (i > Q) L = U;
        int base = 0, ro = 0, es = -1, bs = 0, ros = 0, cs = 0;
#pragma unroll
        for (int e = 0; e < NE; ++e) { const int c = cl[e], mt = (c + 255) >> 8, ue = mt * nN;
            if (es < 0 && L < base + ue) { es = e; bs = base; ros = ro; cs = c; }
            if (i == 0) rowoff[e] = ro;
            base += ue; ro += mt * 256; }
        if (i == 0) rowoff[NE] = ro;
        bool valid = (i < MOE_MAXU && es >= 0 && L < U);
        int pm2 = 0, pn = 0, rows = 0;
        if (valid) {
            const int mt = (cs + 255) >> 8, r = L - bs, mi = r % mt; pn = r / mt;
            pm2 = ros / 128 + 2 * mi; rows = min(256, cs - mi * 256);
            if (half == 0) rows = min(rows, 128);
            if (half == 1) { pm2 += 1; rows -= 128; }
            valid = rows > 0;
        }
        const unsigned long long vm = __ballot(valid);
        if (valid) { const int k = __popcll(vm & ((1ull << i) - 1ull));
            ulist[4 * k + 0] = es; ulist[4 * k + 1] = pm2; ulist[4 * k + 2] = pn; ulist[4 * k + 3] = rows; }
        if (i == 0) *nu = __popcll(vm);
    }
    __syncthreads();
    const int n = *nu;
    if (gather) {
        const int* row_tok = (const int*)(ws + WS_ROWTOK);
        for (int i = F.tid; i < n * 256; i += NWAVES * 64) {
            const int ui = i >> 8, r = i & 255, e = ulist[4 * ui], mi = ulist[4 * ui + 1] - rowoff[e] / 128, rows = ulist[4 * ui + 3];
            const int idx = mi * 128 + (r < rows ? r : 0);
            gtab[i] = (unsigned)row_tok[e * CAP + idx] * (unsigned)DM;
        }
    }
    __syncthreads();
    return n;
}

namespace pg8 {
struct EpiGateUp {
    static constexpr bool PERM = true;
    unsigned char* act; const float* bias; const float* row_rs; const LAS int* rowoff;
    __device__ __forceinline__ void hook(f32x4 (&)[2][2][4][2], const Unit&, int, int, int, int) const {}
    __device__ __forceinline__ void operator()(f32x4 (&acc)[2][2][4][2], const Unit& u, int wr, int wc, int fr, int fq) const {
        const int rl0 = wr * 64 + fr, col0 = u.pn * BM + wc * 32 + 8 * fq;
        const int mi = u.pm - __builtin_amdgcn_readfirstlane(rowoff[u.e]) / 128;
        const float* bp = bias + (size_t)u.e * (2 * DFF) + col0;
        f32x4 bv[2][2];
#pragma unroll
        for (int bj = 0; bj < 2; ++bj)
#pragma unroll
            for (int n = 0; n < 2; ++n) { const f32x4 b = *(const GAS f32x4*)(bp + bj * HALF + 4 * n); bv[bj][n] = (f32x4){b[0], b[2], b[1], b[3]}; }
        float rsv[2][4];
#pragma unroll
        for (int ai = 0; ai < 2; ++ai)
#pragma unroll
            for (int m = 0; m < 4; ++m) rsv[ai][m] = row_rs[(size_t)u.e * CAP + mi * 128 + rl0 + ai * HALF + m * 16] * (1.f / 64.f);
#pragma unroll
        for (int ai = 0; ai < 2; ++ai) {
            if (ai == 1 && u.rows <= HALF) break;
#pragma unroll
            for (int m = 0; m < 4; ++m) {
                const int rl = rl0 + ai * HALF + m * 16;
                const float rs = rsv[ai][m];
                unsigned char* orow = act + (size_t)(u.pm * HALF + rl) * DFF + (col0 >> 1);
#pragma unroll
                for (int bj = 0; bj < 2; ++bj) {
                    f32x2 o[2];
#pragma unroll
                    for (int n = 0; n < 2; ++n) {
                        const f32x4 v = acc[ai][bj][m][n] * rs + bv[bj][n];
                        f32x2 gt = (f32x2){fminf(v[0], 7.f), fminf(v[1], 7.f)}, up = (f32x2){fminf(fmaxf(v[2], -7.f), 7.f), fminf(fmaxf(v[3], -7.f), 7.f)};
                        const f32x2 t = gt * (-1.702f * 1.4426950408889634f);
                        const f32x2 d = (f32x2){__builtin_amdgcn_exp2f(t.x), __builtin_amdgcn_exp2f(t.y)} + 1.f;
                        const f32x2 sg = (f32x2){__builtin_amdgcn_rcpf(d.x), __builtin_amdgcn_rcpf(d.y)};
                        o[n] = (up + 1.f) * (gt * sg);
                    }
                    { int w = __builtin_amdgcn_cvt_pk_fp8_f32(o[0].x, o[0].y, 0, false); w = __builtin_amdgcn_cvt_pk_fp8_f32(o[1].x, o[1].y, w, true); *(GAS unsigned*)(orow + bj * (HALF / 2)) = (unsigned)w; }
                }
            }
        }
    }
};
struct EpiDown {
    static constexpr bool PERM = true;
    unsigned char* y; const float* bias;
    __device__ __forceinline__ void hook(f32x4 (&)[2][2][4][2], const Unit&, int, int, int, int) const {}
    __device__ __forceinline__ void operator()(f32x4 (&acc)[2][2][4][2], const Unit& u, int wr, int wc, int fr, int fq) const {
        const int rl0 = wr * 64 + fr, col0 = u.pn * BM + wc * 32 + 8 * fq;
        const float* bp = bias + (size_t)u.e * DM + col0;
        f32x4 bv[2][2];
#pragma unroll
        for (int bj = 0; bj < 2; ++bj) { bv[bj][0] = *(const GAS f32x4*)(bp + bj * HALF); bv[bj][1] = *(const GAS f32x4*)(bp + bj * HALF + 4); }
#pragma unroll
        for (int ai = 0; ai < 2; ++ai) {
            if (ai == 1 && u.rows <= HALF) break;
#pragma unroll
            for (int m = 0; m < 4; ++m) {
                const int rl = rl0 + ai * HALF + m * 16;
                unsigned char* orow = y + (size_t)(u.pm * HALF + rl) * DM + col0;
#pragma unroll
                for (int bj = 0; bj < 2; ++bj) { const f32x4 v0 = acc[ai][bj][m][0] * (1.f / 64.f) + bv[bj][0], v1 = acc[ai][bj][m][1] * (1.f / 64.f) + bv[bj][1];
                    int w0 = __builtin_amdgcn_cvt_pk_fp8_f32(v0[0], v0[1], 0, false); w0 = __builtin_amdgcn_cvt_pk_fp8_f32(v0[2], v0[3], w0, true);
                    int w1 = __builtin_amdgcn_cvt_pk_fp8_f32(v1[0], v1[1], 0, false); w1 = __builtin_amdgcn_cvt_pk_fp8_f32(v1[2], v1[3], w1, true);
                    *(GAS u32x2*)(orow + bj * HALF) = (u32x2){(unsigned)w0, (unsigned)w1}; }
            }
        }
    }
};
struct EpiPlain {
    static constexpr bool PERM = true;
    bf16_t* O; int ldc;
    __device__ __forceinline__ void hook(f32x4 (&)[2][2][4][2], const Unit&, int, int, int, int) const {}
    __device__ __forceinline__ void operator()(f32x4 (&acc)[2][2][4][2], const Unit& u, int wr, int wc, int fr, int fq) const {
        const int row0 = u.pm * BM + wr * 64 + fr, col0 = u.pn * BM + wc * 32 + 8 * fq;
#pragma unroll
        for (int ai = 0; ai < 2; ++ai)
#pragma unroll
            for (int m = 0; m < 4; ++m) { bf16_t* orow = O + (size_t)(row0 + ai * HALF + m * 16) * ldc + col0;
#pragma unroll
                for (int bj = 0; bj < 2; ++bj) { const f32x4 v0 = acc[ai][bj][m][0], v1 = acc[ai][bj][m][1];
                    *(GAS u32x4*)(orow + bj * HALF) = (u32x4){cvt_pk_bf16(v0[0], v0[1]), cvt_pk_bf16(v0[2], v0[3]), cvt_pk_bf16(v1[0], v1[1]), cvt_pk_bf16(v1[2], v1[3])}; } }
    }
};
struct EpiPle {
    static constexpr bool PERM = true;
    const bf16_t* hin; float* out; const bf16_t* pe; const float* rs3;
    __device__ __forceinline__ void hook(f32x4 (&)[2][2][4][2], const Unit&, int, int, int, int) const {}
    __device__ __forceinline__ void operator()(f32x4 (&acc)[2][2][4][2], const Unit& u, int wr, int wc, int fr, int fq) const {
        const int row0 = u.pm * BM + wr * 64 + fr, col0 = u.pn * BM + wc * 32 + 8 * fq;
        float rsv[2][4];
#pragma unroll
        for (int ai = 0; ai < 2; ++ai)
#pragma unroll
            for (int m = 0; m < 4; ++m) rsv[ai][m] = rs3[row0 + ai * HALF + m * 16] * (1.f / 64.f);
#pragma unroll
        for (int ai = 0; ai < 2; ++ai)
#pragma unroll
            for (int mp = 0; mp < 2; ++mp) {
                u32x4 hq[2][2], pv[2][2];
#pragma unroll
                for (int mm = 0; mm < 2; ++mm) { const size_t off = (size_t)(row0 + ai * HALF + (2 * mp + mm) * 16) * DM + col0;
#pragma unroll
                    for (int bj = 0; bj < 2; ++bj) { pv[mm][bj] = *(const GAS u32x4*)(pe + off + bj * HALF); hq[mm][bj] = *(const GAS u32x4*)(hin + off + bj * HALF); } }
#pragma unroll
                for (int mm = 0; mm < 2; ++mm) { const int m = 2 * mp + mm; const float rs = rsv[ai][m];
                    const size_t off = (size_t)(row0 + ai * HALF + m * 16) * DM + col0;
#pragma unroll
                    for (int bj = 0; bj < 2; ++bj) {
                        const u32x4 h4 = hq[mm][bj]; f32x4 h0 = (f32x4){bflo(h4.x), bfhi(h4.x), bflo(h4.y), bfhi(h4.y)}, h1 = (f32x4){bflo(h4.z), bfhi(h4.z), bflo(h4.w), bfhi(h4.w)}; const u32x4 p4 = pv[mm][bj];
                        const f32x4 a0 = acc[ai][bj][m][0] * rs, a1 = acc[ai][bj][m][1] * rs;
                        const float pf[8] = {bflo(p4.x), bfhi(p4.x), bflo(p4.y), bfhi(p4.y), bflo(p4.z), bfhi(p4.z), bflo(p4.w), bfhi(p4.w)};
#pragma unroll
                        for (int i = 0; i < 4; ++i) {
                            h0[i] += pf[i] * __builtin_amdgcn_rcpf(1.f + __builtin_amdgcn_exp2f(a0[i] * -1.4426950408889634f));
                            h1[i] += pf[4 + i] * __builtin_amdgcn_rcpf(1.f + __builtin_amdgcn_exp2f(a1[i] * -1.4426950408889634f)); }
                        *(GAS f32x4*)(out + off + bj * HALF) = h0; *(GAS f32x4*)(out + off + bj * HALF + 4) = h1;
                    } }
            }
    }
};
}

__device__ __forceinline__ void p7_combine(Frame& F, const Args& a) {
    unsigned char* ws = a.ws;
    const int* cnt = (const int*)(F.ctl + CW_CNT);
    LAS int* rowoff = (LAS int*)(F.lds + XTR_OFF + XTR_ROWOFF);
    __syncthreads();
    if (F.tid < 64) {
        const int c = (F.tid < NE) ? __hip_atomic_load(cnt + 64 * (F.tid & 31), __ATOMIC_RELAXED, __HIP_MEMORY_SCOPE_AGENT) : 0;
        const int pr = ((c + 255) >> 8) * 256; int incl = pr;
#pragma unroll
        for (int o = 1; o < 32; o <<= 1) { const int v = __shfl_up(incl, o); if ((F.tid & 63) >= o) incl += v; }
        if (F.tid <= NE) rowoff[F.tid] = incl - pr;
    }
    __syncthreads();
    const int* tokinfo = (const int*)(ws + WS_TOKINFO); const float* tokgate = (const float*)(ws + WS_TOKINFO + 131072);
    const unsigned char* y = (const unsigned char*)(ws + WS_Y);
    const bf16_t* hin = (const bf16_t*)(ws + WS_HF); bf16_t* out = (bf16_t*)(ws + WS_H2F); unsigned char* h2b = (unsigned char*)(ws + WS_H2B); float* rs3 = (float*)(ws + WS_RS + 32768);
    const int gw = F.vcu * NWAVES + F.wave, NGW = F.G * NWAVES;
    for (int tok = gw; tok < T; tok += NGW) {
        size_t yr[4]; float gk[4];
#pragma unroll
        for (int k = 0; k < 4; ++k) { const int inf = tokinfo[tok * 4 + k]; yr[k] = (size_t)(rowoff[inf >> 16] + (inf & 0xffff)) * DM; gk[k] = tokgate[tok * 4 + k]; }
        float ssq = 0.f;
        GAS u32x2* hp = (GAS u32x2*)(out + (size_t)tok * DM) + F.lane;
        GAS unsigned* bp = (GAS unsigned*)(h2b + (size_t)tok * DM) + F.lane;
        u32x2 hv[8]; unsigned yv[4][8];
#pragma unroll
        for (int j = 0; j < 8; ++j) { hv[j] = __builtin_nontemporal_load((const u32x2*)(hin + (size_t)tok * DM) + 64 * j + F.lane);
#pragma unroll
            for (int k = 0; k < 4; ++k) yv[k][j] = __builtin_nontemporal_load((const unsigned*)(y + yr[k]) + 64 * j + F.lane); }
#pragma unroll
        for (int j = 0; j < 8; ++j) {
            f32x4 v = (f32x4){bflo(hv[j].x), bfhi(hv[j].x), bflo(hv[j].y), bfhi(hv[j].y)};
#pragma unroll
            for (int k = 0; k < 4; ++k) { f32x2 lo, hi;
                asm volatile("v_cvt_pk_f32_fp8_e32 %0, %2\n\tv_cvt_pk_f32_fp8_sdwa %1, %2 src0_sel:WORD_1" : "=&v"(lo), "=&v"(hi) : "v"(yv[k][j]));
                v.x += gk[k] * lo.x; v.y += gk[k] * lo.y; v.z += gk[k] * hi.x; v.w += gk[k] * hi.y; }
            hp[64 * j] = (u32x2){cvt_pk_bf16(v.x, v.y), cvt_pk_bf16(v.z, v.w)}; { int w = __builtin_amdgcn_cvt_pk_fp8_f32(v.x, v.y, 0, false); w = __builtin_amdgcn_cvt_pk_fp8_f32(v.z, v.w, w, true); bp[64 * j] = (unsigned)w; }
            ssq += (v.x * v.x + v.y * v.y) + (v.z * v.z + v.w * v.w);
        }
        ssq = wave_sum(ssq);
        if (F.lane == 0) rs3[tok] = rsqrtf(ssq * (1.f / DM) + EPS);
    }
}
#ifndef CONV_ROWS_MASK
#define CONV_ROWS_MASK 0xa94a5294u
#endif
#ifndef PH_MOE_CONVERT
#define PH_MOE_CONVERT 1
#endif
__global__ void __launch_bounds__(NWAVES * 64, 2) mk_fwd(Args args) {
    extern __shared__ __attribute__((aligned(16))) unsigned char lds_raw[];
    Frame F;
    F.lds = (LAS unsigned char*)lds_raw;
    F.MISC = (volatile LAS unsigned*)(F.lds + MISC_OFF);
    F.tid = threadIdx.x; F.lane = F.tid & 63; F.wave = __builtin_amdgcn_readfirstlane(F.tid >> 6);
    F.G = gridDim.x; { const int bx = blockIdx.x; F.vcu = (F.G % 8 == 0) ? (bx % 8) * (F.G / 8) + bx / 8 : bx; }
    { const int bx = blockIdx.x; const bool split = (F.G == 256); const int row = bx >> 3; constexpr unsigned CONV_MASK = CONV_ROWS_MASK;
      F.conv = split && ((CONV_MASK >> row) & 1u); F.cG = split ? 8 * (32 - __builtin_popcount(CONV_MASK)) : F.G;
      const int crow = row - __builtin_popcount(CONV_MASK & ((1u << row) - 1u));
      F.cidx = split ? ((crow << 3) | (bx & 7)) : bx;
      F.cvcu = (F.cG % 8 == 0) ? (F.cidx % 8) * (F.cG / 8) + F.cidx / 8 : F.cidx; }
    unsigned char* ws = args.ws;
    F.ctl = (unsigned*)(ws + WS_CTL);
    for (int u = F.tid; u < 64; u += NWAVES * 64) F.MISC[u] = 0u;
    __syncthreads();
    XcdBarrier bar = xcd_barrier_post(F.ctl + CW_BAR, F.MISC + 8, (unsigned)F.G);
    XcdBarrier bar2; bar2.bar = F.ctl + CW_BAR2; bar2.x = 0; bar2.st = F.MISC + 24; bar2.total = (unsigned)F.cG;
    if (!F.conv) bar2 = xcd_barrier_post(F.ctl + CW_BAR2, F.MISC + 24, (unsigned)F.cG);
    const int lo = args.ph_lo, hi = args.ph_hi;
#define IN(k) (lo <= (k) && (k) < hi)
#define BOTH(k) (IN(k) && IN((k) + 1))

    if (IN(0)) {
        if (F.cG < F.G) { if (!F.conv) { Frame F2 = F; F2.vcu = F.cvcu; F2.G = F.cG; p0_prologue(F2, args); if (BOTH(0)) xcd_barrier(bar2); } }
        else { p0_prologue(F, args); if (BOTH(0)) xcd_barrier(bar); }
    }
    if (IN(1)) { REFRESH();
        if (F.conv) {
            moe_convert_pull(F, args);
        } else {
            {
                pg8::DenseOrder S; S.init(ws + WS_XB, ws + WS_WIN, T, DIN, DM * 2, F.cG, F.cidx);
                pg8::EpiProj E{(bf16_t*)(ws + WS_PROJ), (float*)(ws + WS_STATS)};
                pg8::gemm_phase<pg8::EpiProj, pg8::DenseOrder, true, false, false>(F.lds, DM * 2, S, E);
            }
            {
                pg8::DenseOrder S2; S2.init(ws + WS_PB, ws + WS_WPLE, T, DM, DPLE * 2, F.cG, F.cidx);
                pg8::EpiPlain E2{(bf16_t*)(ws + WS_PE), DM};
                int kple = DPLE * 2; asm volatile("" : "+s"(kple));
                pg8::gemm_phase<pg8::EpiPlain, pg8::DenseOrder, true, false, false>(F.lds, kple, S2, E2);
            }
            xcd_barrier(bar2); REFRESH();
            p2_mixers(F, args);
            xcd_barrier(bar2);
#ifndef P3_FILL
#define P3_FILL 3
#endif
            {
                pg8::DenseOrder S; S.init(ws + WS_MG, ws + WS_WOUT, T, DM, DM * 2, F.cG, F.cidx);
                LAS f32x2* tab = (LAS f32x2*)(F.lds + XTR_OFF);
                pg8::p3_rowtab(tab, S, (const float*)(ws + WS_ASS), (const float*)(ws + WS_SSS), 8);
                pg8::EpiOut E{args.in[0], (bf16_t*)(ws + WS_HF), (unsigned char*)(ws + WS_HB), tab};
                pg8::gemm_phase<pg8::EpiOut, pg8::DenseOrder, true, false, true>(F.lds, DM * 2, S, E);
            }
            if (F.cG < F.G && F.cidx >= (T / 256) * (DM / 256) - F.cG) { REFRESH(); moe_convert_pull(F, args, P3_FILL); }
            xcd_barrier(bar2); REFRESH();
            p4_router(F, args);
            REFRESH();
            moe_convert_pull(F, args);
        }
        if (BOTH(1) || IN(5)) xcd_barrier(bar);
    }
    if (IN(5)) { REFRESH();
        const int n = moe_build(F, args, 2 * DFF / 256, true);
        MoeOrder S{(const char*)(ws + WS_HB), (const char*)(ws + WS_WGU), (size_t)2 * DFF * DM, DM, true, (const LAS int*)(F.lds + XTR_OFF + XTR_ULIST), (const LAS unsigned*)(F.lds + XTR_OFF + XTR_GTAB), n};
        pg8::EpiGateUp E{(unsigned char*)(ws + WS_ACT), args.in[18], (const float*)(ws + WS_ROWRS), (const LAS int*)(F.lds + XTR_OFF + XTR_ROWOFF)};
        pg8::gemm_phase<pg8::EpiGateUp, MoeOrder, true, true, false, true, true>(F.lds, DM, S, E);
        if (BOTH(5)) xcd_barrier(bar);
    }
    if (IN(6)) { REFRESH();
        const int n = moe_build(F, args, DM / 256, false);
        MoeOrder S{(const char*)(ws + WS_ACT), (const char*)(ws + WS_WDN), (size_t)DM * DFF, DFF, false, (const LAS int*)(F.lds + XTR_OFF + XTR_ULIST), (const LAS unsigned*)(F.lds + XTR_OFF + XTR_GTAB), n};
        pg8::EpiDown E{(unsigned char*)(ws + WS_Y), args.in[20]};
        pg8::gemm_phase<pg8::EpiDown, MoeOrder, true, false, false, true, true>(F.lds, DFF, S, E);
        if (BOTH(6)) xcd_barrier(bar);
    }
    if (IN(7)) { REFRESH(); p7_combine(F, args); if (BOTH(7)) xcd_barrier(bar); }
    if (IN(8)) { REFRESH();
        pg8::DenseOrder S; S.init(ws + WS_H2B, ws + WS_WPG, T, DM, DM, F.G, (int)blockIdx.x);
        pg8::EpiPle E{(const bf16_t*)(ws + WS_H2F), args.out, (const bf16_t*)(ws + WS_PE), (const float*)(ws + WS_RS + 32768)};
        pg8::gemm_phase<pg8::EpiPle, pg8::DenseOrder, true, false, false, true>(F.lds, DM, S, E);
    }
#undef IN
#undef BOTH
}
extern "C" void kernel_launch(void* const* d_in, const int* in_sizes, int n_in, void* d_out, int out_size, void* d_ws, size_t ws_size, hipStream_t stream) {
    static int grid = 0;
    if (grid == 0) {
        int dev = 0, cus = 0;
        if (n_in != 24 || out_size != T * DM || ws_size < WS_END) { fprintf(stderr, "kernel_launch: built for 24 inputs, %d outputs, >= %zu bytes of workspace\n", T * DM, (size_t)WS_END); grid = -1; return; }
        if (hipGetDevice(&dev) != hipSuccess || hipDeviceGetAttribute(&cus, hipDeviceAttributeMultiprocessorCount, dev) != hipSuccess) { fprintf(stderr, "kernel_launch: device query failed\n"); grid = -1; return; }
        if (hipFuncSetAttribute((const void*)mk_fwd, hipFuncAttributeMaxDynamicSharedMemorySize, LDS_BYTES) != hipSuccess) { fprintf(stderr, "kernel_launch: hipFuncSetAttribute failed\n"); grid = -1; return; }
        (void)hipGetLastError();
        grid = cus;
    }
    if (grid < 0) return;
    (void)hipMemsetAsync((char*)d_ws + WS_CTL, 0, CTL_ZERO_BYTES, stream);
    Args a{};
    for (int i = 0; i < 24; ++i) a.in[i] = (const float*)d_in[i];
    a.out = (float*)d_out; a.ws = (unsigned char*)d_ws;
    a.ph_lo = 0; a.ph_hi = 9;
    hipLaunchKernelGGL(mk_fwd, dim3(grid), dim3(NWAVES * 64), LDS_BYTES, stream, a);
}
```

```cpp
#include <hip/hip_runtime.h>
#include <stdint.h>
#include <cstdio>

constexpr int T = 8192, DM = 2048, DPLE = 256;
constexpr int NQH = 16, NKVH = 4, HD = 64, WIN = 128;
constexpr int NSG = 8, SGD = 128, SGC = 128;
constexpr int DATT = 1024, DKV = 256, DSG = 1024, DIN = 3584;
constexpr int NE = 32, TOPK = 4, DFF = 2048;
constexpr float EPS = 1e-6f;
constexpr int QOFF = 0, KOFF = 1024, VOFF = 1280, UOFF = 1536, GOFF = 2560;
constexpr int CAP = T;
constexpr int MAXROWS = T * TOPK + NE * 256;

#define GAS __attribute__((address_space(1)))
#define LAS __attribute__((address_space(3)))
typedef unsigned short bf16_t;
typedef short bf16x8 __attribute__((ext_vector_type(8)));
typedef float f32x4 __attribute__((ext_vector_type(4)));
typedef float f32x2 __attribute__((ext_vector_type(2)));
typedef float f32x16 __attribute__((ext_vector_type(16)));
typedef unsigned u32x4 __attribute__((ext_vector_type(4)));
typedef unsigned u32x2 __attribute__((ext_vector_type(2)));

__device__ __forceinline__ unsigned cvt_pk_bf16(float lo, float hi) { unsigned r; asm volatile("v_cvt_pk_bf16_f32 %0, %1, %2" : "=v"(r) : "v"(lo), "v"(hi)); return r; }
__device__ __forceinline__ float bf2f(unsigned short b) { return __builtin_bit_cast(float, (unsigned)b << 16); }
__device__ __forceinline__ float bflo(unsigned w) { return __builtin_bit_cast(float, w << 16); }
__device__ __forceinline__ float bfhi(unsigned w) { return __builtin_bit_cast(float, w & 0xffff0000u); }
constexpr int DPP_X1 = 0xB1, DPP_X2 = 0x4E, DPP_HM = 0x141, DPP_X8 = 0x128;
template <int CTRL> __device__ __forceinline__ float dpp_f(float v) { return __builtin_bit_cast(float, __builtin_amdgcn_update_dpp(0, __builtin_bit_cast(int, v), CTRL, 0xF, 0xF, true)); }
template <int CTRL> __device__ __forceinline__ int dpp_i(int v) { return __builtin_amdgcn_update_dpp(0, v, CTRL, 0xF, 0xF, true); }
__device__ __forceinline__ f32x2 halves_f(float v) { const unsigned b = __builtin_bit_cast(unsigned, v); const auto r = __builtin_amdgcn_permlane32_swap(b, b, false, false);
    return (f32x2){__builtin_bit_cast(float, (unsigned)r[0]), __builtin_bit_cast(float, (unsigned)r[1])}; }
__device__ __forceinline__ float sum_halves(float v) { const f32x2 r = halves_f(v); return r.x + r.y; }
__device__ __forceinline__ float sum_rowpair(float v) { const unsigned b = __builtin_bit_cast(unsigned, v); const auto r = __builtin_amdgcn_permlane16_swap(b, b, false, false);
    return __builtin_bit_cast(float, (unsigned)r[0]) + __builtin_bit_cast(float, (unsigned)r[1]); }
__device__ __forceinline__ float sum8(float v) { v += dpp_f<DPP_X1>(v); v += dpp_f<DPP_X2>(v); v += dpp_f<DPP_HM>(v); return v; }
__device__ __forceinline__ float wave_sum(float v) {
    v = sum_halves(v); v = sum_rowpair(v); v += dpp_f<DPP_X8>(v);
    return sum8(v);
}
#define LDS_WAIT() asm volatile("s_waitcnt lgkmcnt(0)" ::: "memory")
#define VM_WAIT() asm volatile("s_waitcnt vmcnt(0)" ::: "memory")

constexpr size_t MiB = 1u << 20;
constexpr size_t WS_CTL = 0, CTL_ZERO_BYTES = 65536;
constexpr size_t WS_WIN = 2 * MiB;
constexpr size_t WS_WOUT = 16 * MiB;
constexpr size_t WS_WPG = 24 * MiB;
constexpr size_t WS_WPLE = 32 * MiB;
constexpr size_t WS_WSP = 33 * MiB;
constexpr size_t WS_WR = 34 * MiB;
constexpr size_t WS_STATS = 35 * MiB;
constexpr size_t WS_ASS = 36 * MiB;
constexpr size_t WS_SSS = 37 * MiB;
constexpr size_t WS_RS = 38 * MiB;
constexpr size_t WS_TOKINFO = 39 * MiB;
constexpr size_t WS_ROWTOK = 40 * MiB;
constexpr size_t WS_ROWRS = 41 * MiB;
constexpr size_t WS_XB = 48 * MiB;
constexpr size_t WS_PB = 80 * MiB;
constexpr size_t WS_PE = 84 * MiB;
constexpr size_t WS_PROJ = 116 * MiB;
constexpr size_t WS_MG = 172 * MiB;
constexpr size_t WS_HB = 204 * MiB;
constexpr size_t WS_H2B = 236 * MiB;
constexpr size_t WS_ACT = 268 * MiB;
constexpr size_t WS_Y = 432 * MiB;
constexpr size_t WS_WGU = 600 * MiB;
constexpr size_t WS_WDN = 1112 * MiB;
constexpr size_t WS_HF = 1368 * MiB;
constexpr size_t WS_H2F = 1432 * MiB;
constexpr size_t WS_END = 1496 * MiB;

constexpr int CW_CNT = 64;
constexpr int CW_BAR = 4096;
constexpr int CW_BAR2 = 12288;
constexpr int CW_QHEAD = 8192;
constexpr int CW_DONE = 8192 + 64;

#define XB_TMO      128
#define XB_XCNT(j)  (256  + 64 * (j))
#define XB_XSUB(j)  (1280 + 64 * (j))
#define XB_XGEN(j)  (2304 + 64 * (j))
#define XB_TOP      3328
#define XB_TOPGEN   3392
#define XCD_BAR_WORDS 3456
#define XB_SPIN_CAP (1u << 18)
__device__ __forceinline__ unsigned xb_ld(unsigned* p)              { return __hip_atomic_load(p, __ATOMIC_RELAXED, __HIP_MEMORY_SCOPE_AGENT); }
__device__ __forceinline__ unsigned xb_add(unsigned* p, unsigned v) { return __hip_atomic_fetch_add(p, v, __ATOMIC_RELAXED, __HIP_MEMORY_SCOPE_AGENT); }
__device__ __forceinline__ unsigned xb_xcc_id() { return (unsigned)__builtin_amdgcn_s_getreg((3 << 11) | 20) & 0xFu; }
#define XB_SPIN(cond, bar) do { unsigned _sp = 0; while (cond) { __builtin_amdgcn_s_sleep(1); \
    if ((++_sp & 255u) == 0u) { if (xb_ld(&(bar)[XB_TMO])) break; if (_sp > XB_SPIN_CAP) { atomicAdd(&(bar)[XB_TMO], 1u); break; } } } } while (0)
struct XcdBarrier { unsigned* bar; unsigned x; volatile LAS unsigned* st; unsigned total; };
__device__ __forceinline__ XcdBarrier xcd_barrier_post(unsigned* bar, volatile LAS unsigned* st, unsigned total) {
    XcdBarrier b; b.bar = bar; b.x = xb_xcc_id(); b.st = st; b.total = total;
    if (threadIdx.x == 0) (void)xb_add(&bar[XB_XCNT(b.x)], 1u);
    return b;
}
__device__ __forceinline__ void xcd_barrier_complete(unsigned* bar, unsigned x, unsigned G, unsigned& nloc, unsigned& nx) {
    unsigned sum, cnt, mine, sp = 0u;
    for (;;) {
        sum = 0u; cnt = 0u; mine = 0u;
#pragma unroll
        for (unsigned j = 0; j < 16; ++j) { const unsigned c = xb_ld(&bar[XB_XCNT(j)]); sum += c; cnt += (c > 0u) ? 1u : 0u; mine = (j == x) ? c : mine; }
        if (sum == G) break;
        __builtin_amdgcn_s_sleep(1);
        if ((++sp & 255u) == 0u) { if (xb_ld(&bar[XB_TMO])) break; if (sp > XB_SPIN_CAP) { atomicAdd(&bar[XB_TMO], 1u); break; } }
    }
    nloc = mine > 0u ? mine : 1u; nx = cnt > 0u ? cnt : 1u;
}
__device__ __forceinline__ void xcd_barrier(const XcdBarrier& b) {
    asm volatile("s_waitcnt vmcnt(0)" ::: "memory");
    __syncthreads();
    if (threadIdx.x == 0) {
        unsigned* bar = b.bar;
        __builtin_amdgcn_s_waitcnt(0);
        unsigned nloc = b.st[0], nx = b.st[1];
        if (nloc == 0u) { xcd_barrier_complete(bar, b.x, b.total, nloc, nx); b.st[0] = nloc; b.st[1] = nx; }
        const unsigned old = xb_add(&bar[XB_XSUB(b.x)], 1u);
        const unsigned gen = old / nloc;
        if (old + 1u == (gen + 1u) * nloc) {
            __builtin_amdgcn_fence(__ATOMIC_RELEASE, "agent");
            asm volatile("s_waitcnt vmcnt(0)" ::: "memory");
            const unsigned og = xb_add(&bar[XB_TOP], 1u);
            const unsigned tg = og / nx;
            if (og + 1u == (tg + 1u) * nx) xb_add(&bar[XB_TOPGEN], 1u);
            else XB_SPIN(xb_ld(&bar[XB_TOPGEN]) == tg, bar);
            __builtin_amdgcn_fence(__ATOMIC_ACQUIRE, "agent");
            xb_add(&bar[XB_XGEN(b.x)], 1u);
            asm volatile("s_waitcnt vmcnt(0)" ::: "memory");
        } else {
            XB_SPIN(xb_ld(&bar[XB_XGEN(b.x)]) == gen, bar);
            __builtin_amdgcn_fence(__ATOMIC_ACQUIRE, "agent");
            asm volatile("s_waitcnt vmcnt(0)" ::: "memory");
        }
    }
    __syncthreads();
}

constexpr int NWAVES = 8;
constexpr int RING_BYTES = 131072;
constexpr int XTR_OFF = RING_BYTES;
constexpr int MISC_OFF = RING_BYTES + 28672;
constexpr int LDS_BYTES = 163840;

struct Args { const float* in[24]; float* out; unsigned char* ws; int ph_lo, ph_hi; };
#define REFRESH() do { int tz_ = threadIdx.x; asm volatile("" : "+v"(tz_)); F.tid = tz_; F.lane = tz_ & 63; } while (0)
struct Frame { LAS unsigned char* lds; volatile LAS unsigned* MISC; unsigned* ctl; int tid, lane, wave, G, vcu; int cG, cidx, cvcu; bool conv; };
namespace pg8 {
constexpr int BM = 256, BK = 64, HALF = 128, HTB = HALF * BK * 2, STAGE_BYTES = 8 * HTB, NXCD = 8, WGM = 8;
__host__ __device__ __forceinline__ int lds_byte(int r, int c) { const int st = (r >> 4) * 2 + (c >> 5), rr = r & 15, cc = c & 31, ob = rr * 64 + cc * 2; return st * 1024 + (ob ^ (((ob >> 9) & 1) << 5)); }
__host__ __device__ __forceinline__ void stage_rc(int b, int& R, int& C) { const int st = b / 1024, sb = b % 1024, swz = sb ^ (((sb >> 9) & 1) << 5); R = (st >> 1) * 16 + swz / 64; C = (st & 1) * 32 + (swz % 64) / 2; }
__host__ __device__ __forceinline__ int perm32(int rho) { const int n = rho >> 4, i = rho & 15; return 8 * (i >> 2) + 4 * n + (i & 3); }

struct Unit { int pm, pn, e, rows, idx; };
typedef int i32x4 __attribute__((ext_vector_type(4)));
typedef int i32x8 __attribute__((ext_vector_type(8)));
__device__ __forceinline__ i32x8 cat8(bf16x8 a, bf16x8 b) { const i32x4 x = __builtin_bit_cast(i32x4, a), y = __builtin_bit_cast(i32x4, b); return __builtin_shufflevector(x, y, 0, 1, 2, 3, 4, 5, 6, 7); }

struct DenseOrder {
    const char* A; const char* Bt; int rb; int nM, nN, nwg, G, c;
    __device__ void init(const void* A_, const void* Bt_, int M, int N, int rb_, int G_, int c_) { A = (const char*)A_; Bt = (const char*)Bt_; rb = rb_; nM = M / BM; nN = N / BM; nwg = nM * nN; G = G_; c = c_; }
    __device__ bool next(int i, Unit& u) const {
        const long L = (long)i * G + c; if (L >= nwg) return false;
        int wgid = (int)L; { const int q = nwg / NXCD, r = nwg % NXCD, xcd = wgid % NXCD, off = wgid / NXCD; wgid = (xcd < r ? xcd * (q + 1) : r * (q + 1) + (xcd - r) * q) + off; }
        const int nig = WGM * nN, gid = wgid / nig, fm = gid * WGM, gsz = (nM - fm) < WGM ? (nM - fm) : WGM;
        u.pm = fm + ((wgid % nig) % gsz); u.pn = (wgid % nig) / gsz; u.e = 0; u.rows = BM; u.idx = i; return true;
    }
    __device__ __forceinline__ const char* a_ptr(const Unit& u) const { return A + (size_t)u.pm * ((size_t)BM * rb); }
    __device__ __forceinline__ const char* b_ptr(const Unit& u) const { return Bt + (size_t)u.pn * ((size_t)BM * rb); }
    __device__ __forceinline__ unsigned gather_off(int, int) const { return 0u; }
};

template <class Epi, class Sched, bool ALIGN_EPI, bool GATHER, bool HOOK, bool F8 = false, bool HALFSKIP = false>
__device__ __forceinline__ void gemm_phase(LAS unsigned char* lds, const int KB, const Sched& S, const Epi& E) {
    const int tid = threadIdx.x, wid = __builtin_amdgcn_readfirstlane(tid >> 6), lane = tid & 63, wr = wid >> 2, wc = wid & 3, fr = lane & 15, fq = lane >> 4;
    const int nt = KB / 128;
    unsigned voffA[2], voffB[2]; int rowA[2];
#pragma unroll
    for (int i = 0; i < 2; ++i) { int R, C; stage_rc(tid * 16 + i * 8192, R, C); const int Rb = Epi::PERM ? ((R & ~31) + perm32(R & 31)) : R;
        voffA[i] = (unsigned)(R * KB + C * 2); voffB[i] = (unsigned)(Rb * KB + C * 2); rowA[i] = R; if (GATHER) voffA[i] = (unsigned)C * 2u; }
    const size_t kstep = (size_t)(BK * 2);
    const unsigned hstep = (unsigned)HALF * KB;
    const unsigned ldsw = (unsigned)wid * 1024u;
    const int aoff = lds_byte(wr * 64 + fr, fq * 8), boff = lds_byte(wc * 32 + fr, fq * 8);
#define PG8_SA(b, h) (((b) * 2 + (h)) * HTB)
#define PG8_SB(b, h) ((4 + (b) * 2 + (h)) * HTB)
#define PG8_STAGE_B(bufoff, gbase, hh) do { _Pragma("unroll") for (int _i = 0; _i < 2; ++_i) \
        __builtin_amdgcn_global_load_lds((const unsigned*)((const char*)(gbase) + (voffB[_i] + (hh) * hstep)), (LAS unsigned*)(lds + (bufoff) + ldsw + _i * 8192), 16, 0, 0); } while (0)
#define PG8_STAGE_A(bufoff, gbase, OFF, hh) do { _Pragma("unroll") for (int _i = 0; _i < 2; ++_i) \
        __builtin_amdgcn_global_load_lds((const unsigned*)((const char*)(gbase) + (OFF)[hh][_i]), (LAS unsigned*)(lds + (bufoff) + ldsw + _i * 8192), 16, 0, 0); } while (0)
#define PG8_LDA(dst, b, h) do { _Pragma("unroll") for (int m = 0; m < 4; ++m) { if constexpr (F8) dst##8[m] = __builtin_shufflevector(*(const LAS i32x4*)(lds + PG8_SA(b, h) + aoff + m * 2048), *(const LAS i32x4*)(lds + PG8_SA(b, h) + aoff + m * 2048 + 1024), 0, 1, 2, 3, 4, 5, 6, 7); \
        else { _Pragma("unroll") for (int k = 0; k < 2; ++k) dst[m][k] = *(const LAS bf16x8*)(lds + PG8_SA(b, h) + aoff + m * 2048 + k * 1024); } } } while (0)
#define PG8_LDB(dst, b, h) do { _Pragma("unroll") for (int n = 0; n < 2; ++n) { if constexpr (F8) dst##8[n] = __builtin_shufflevector(*(const LAS i32x4*)(lds + PG8_SB(b, h) + boff + n * 2048), *(const LAS i32x4*)(lds + PG8_SB(b, h) + boff + n * 2048 + 1024), 0, 1, 2, 3, 4, 5, 6, 7); \
        else { _Pragma("unroll") for (int k = 0; k < 2; ++k) dst[n][k] = *(const LAS bf16x8*)(lds + PG8_SB(b, h) + boff + n * 2048 + k * 1024); } } } while (0)
#define PG8_MMA(ai, bj, At, Bt) do { __builtin_amdgcn_s_setprio(1); _Pragma("unroll") for (int m = 0; m < 4; ++m) _Pragma("unroll") for (int n = 0; n < 2; ++n) { \
        if constexpr (F8) asm volatile("v_mfma_f32_16x16x128_f8f6f4 %0, %1, %2, %0" : "+v"(acc[ai][bj][m][n]) : "v"(Bt##8[n]), "v"(At##8[m])); \
        else { _Pragma("unroll") for (int k = 0; k < 2; ++k) acc[ai][bj][m][n] = __builtin_amdgcn_mfma_f32_16x16x32_bf16(Bt[n][k], At[m][k], acc[ai][bj][m][n], 0, 0, 0); } } \
        __builtin_amdgcn_s_setprio(0); } while (0)
#define PG8_WAIT_V(n) asm volatile("s_waitcnt vmcnt(" #n ")" ::: "memory")
#define PG8_WAIT_L(n) asm volatile("s_waitcnt lgkmcnt(" #n ")" ::: "memory")
#define PG8_BAR __builtin_amdgcn_s_barrier()
#define PG8_SCHED __builtin_amdgcn_sched_barrier(0)
    Unit cur, nxt; int ui = 0;
    if (!S.next(0, cur)) return;
    f32x4 acc[2][2][4][2];
#pragma unroll
    for (int a = 0; a < 2; ++a)
#pragma unroll
        for (int b = 0; b < 2; ++b)
#pragma unroll
            for (int m = 0; m < 4; ++m)
#pragma unroll
                for (int n = 0; n < 2; ++n) acc[a][b][m][n] = (f32x4){0.f, 0.f, 0.f, 0.f};
    bf16x8 At[4][2], B0[2][2], B1[2][2];
    i32x8 At8[4], B08[2], B18[2];
    const char* cA = S.a_ptr(cur); const char* cB = S.b_ptr(cur);
    unsigned offA[2][2], offN[2][2];
#pragma unroll
    for (int h = 0; h < 2; ++h)
#pragma unroll
        for (int i = 0; i < 2; ++i) { offA[h][i] = GATHER ? (S.gather_off(0, h * HALF + rowA[i]) + voffA[i]) : (voffA[i] + h * hstep); offN[h][i] = offA[h][i]; }
    PG8_STAGE_B(PG8_SB(0, 0), cB, 0); PG8_STAGE_B(PG8_SB(0, 1), cB, 1); PG8_STAGE_A(PG8_SA(0, 0), cA, offA, 0); PG8_STAGE_A(PG8_SA(0, 1), cA, offA, 1);
    if (wr == 1) PG8_BAR;
    PG8_WAIT_V(2); PG8_BAR;
    PG8_STAGE_B(PG8_SB(1, 0), cB + kstep, 0); PG8_STAGE_A(PG8_SA(1, 0), cA + kstep, offA, 0); PG8_STAGE_B(PG8_SB(1, 1), cB + kstep, 1);
    PG8_WAIT_V(6); PG8_BAR;
    for (;;) {
        const bool has_next = S.next(ui + 1, nxt);
        const char* nA = has_next ? S.a_ptr(nxt) : cA; const char* nB = has_next ? S.b_ptr(nxt) : cB;
        if (GATHER) {
#pragma unroll
            for (int h = 0; h < 2; ++h)
#pragma unroll
                for (int i = 0; i < 2; ++i) offN[h][i] = has_next ? (S.gather_off(ui + 1, h * HALF + rowA[i]) + voffA[i]) : offA[h][i];
        }
        const bool full = cur.rows > HALF;
        for (int t = 0; t < nt; t += 2) {
            const bool last = (t == nt - 2);
            const char* a1 = cA + (size_t)(t + 1) * kstep;
            const char* a2 = last ? nA : cA + (size_t)(t + 2) * kstep; const char* b2 = last ? nB : cB + (size_t)(t + 2) * kstep;
            const char* a3 = a2 + kstep; const char* b3 = b2 + kstep;
            unsigned o2[2][2];
#pragma unroll
            for (int h = 0; h < 2; ++h)
#pragma unroll
                for (int i = 0; i < 2; ++i) o2[h][i] = (GATHER && last) ? offN[h][i] : offA[h][i];
            if (HOOK) { if (t == nt / 2) E.hook(acc, cur, wr, wc, fr, fq); }
            PG8_LDB(B0, 0, 0); PG8_LDB(B1, 0, 1); PG8_SCHED; PG8_LDA(At, 0, 0); PG8_STAGE_A(PG8_SA(1, 1), a1, offA, 1);
            PG8_WAIT_V(8); PG8_WAIT_L(0); PG8_BAR; PG8_MMA(0, 0, At, B0); PG8_MMA(0, 1, At, B1); PG8_BAR; PG8_SCHED;
            PG8_LDA(At, 0, 1); PG8_STAGE_B(PG8_SB(0, 0), b2, 0); PG8_STAGE_B(PG8_SB(0, 1), b2, 1); PG8_STAGE_A(PG8_SA(0, 0), a2, o2, 0);
            PG8_WAIT_V(8); PG8_WAIT_L(0); PG8_BAR; if (!HALFSKIP || full) { PG8_MMA(1, 0, At, B0); PG8_MMA(1, 1, At, B1); } PG8_BAR; PG8_SCHED;
            PG8_LDB(B0, 1, 0); PG8_LDB(B1, 1, 1); PG8_SCHED; PG8_LDA(At, 1, 0); PG8_STAGE_A(PG8_SA(0, 1), a2, o2, 1);
            PG8_WAIT_V(8); PG8_WAIT_L(0); PG8_BAR; PG8_MMA(0, 0, At, B0); PG8_MMA(0, 1, At, B1); PG8_BAR; PG8_SCHED;
            PG8_LDA(At, 1, 1); PG8_STAGE_B(PG8_SB(1, 0), b3, 0); PG8_STAGE_B(PG8_SB(1, 1), b3, 1); PG8_STAGE_A(PG8_SA(1, 0), a3, o2, 0);
            PG8_WAIT_V(8); PG8_WAIT_L(0); PG8_BAR; if (!HALFSKIP || full) { PG8_MMA(1, 0, At, B0); PG8_MMA(1, 1, At, B1); } PG8_BAR; PG8_SCHED;
        }
        if constexpr (ALIGN_EPI) { if (wr == 0) PG8_BAR; }
        if constexpr (F8) asm volatile("s_nop 15\n\ts_nop 7" ::: "memory");
        E(acc, cur, wr, wc, fr, fq);
        if (!has_next) break;
#pragma unroll
        for (int a = 0; a < 2; ++a)
#pragma unroll
            for (int b = 0; b < 2; ++b)
#pragma unroll
                for (int m = 0; m < 4; ++m)
#pragma unroll
                    for (int n = 0; n < 2; ++n) acc[a][b][m][n] = (f32x4){0.f, 0.f, 0.f, 0.f};
        cur = nxt; cA = nA; cB = nB; ++ui;
#pragma unroll
        for (int h = 0; h < 2; ++h)
#pragma unroll
            for (int i = 0; i < 2; ++i) offA[h][i] = offN[h][i];
        if constexpr (ALIGN_EPI) { if (wr == 1) PG8_BAR; }
    }
    PG8_WAIT_V(0);
    if constexpr (!ALIGN_EPI) { if (wr == 0) PG8_BAR; }
    PG8_BAR;
#undef PG8_SA
#undef PG8_SB
#undef PG8_STAGE_A
#undef PG8_STAGE_B
#undef PG8_LDA
#undef PG8_LDB
#undef PG8_MMA
#undef PG8_WAIT_V
#undef PG8_WAIT_L
#undef PG8_BAR
#undef PG8_SCHED
}

__device__ __forceinline__ f32x2 gelu_pk(f32x2 v) {
    const f32x2 av = __builtin_elementwise_abs(v), d = av * 0.2316418882f + 1.0f;
    f32x2 t; t.x = __builtin_amdgcn_rcpf(d.x); t.y = __builtin_amdgcn_rcpf(d.y);
    f32x2 q = t * 0.5307027145f + (-0.7265760135f); q = q * t + 0.7107068705f; q = q * t + (-0.142248368f); q = q * t + 0.127414796f; q = q * t;
    const f32x2 s = (v * v) * (-0.72134752044f);
    f32x2 e; e.x = __builtin_amdgcn_exp2f(s.x); e.y = __builtin_amdgcn_exp2f(s.y);
    const f32x2 m = v * (q * e), r = v - m;
    f32x2 o; o.x = v.x < 0.f ? m.x : r.x; o.y = v.y < 0.f ? m.y : r.y; return o;
}

struct EpiProj {
    static constexpr bool PERM = true;
    bf16_t* O; float* stats;
    __device__ __forceinline__ void hook(f32x4 (&)[2][2][4][2], const Unit&, int, int, int, int) const {}
    __device__ __forceinline__ void operator()(f32x4 (&acc)[2][2][4][2], const Unit& u, int wr, int wc, int fr, int fq) const {
        const int row0 = u.pm * BM + wr * 64 + fr, col0 = u.pn * BM + wc * 32 + 8 * fq;
        const bool act = (u.pn * BM >= UOFF), st = (u.pn * BM >= GOFF);
#pragma unroll
        for (int ai = 0; ai < 2; ++ai)
#pragma unroll
            for (int m = 0; m < 4; ++m) {
                const int row = row0 + ai * HALF + m * 16;
                bf16_t* rowp = O + (size_t)row * DIN + col0;
                float s = 0.f, ss = 0.f;
#pragma unroll
                for (int bj = 0; bj < 2; ++bj) {
                    f32x4 v0 = acc[ai][bj][m][0], v1 = acc[ai][bj][m][1];
                    if (act) { f32x2 a = gelu_pk((f32x2){v0[0], v0[1]}), b = gelu_pk((f32x2){v0[2], v0[3]}), c = gelu_pk((f32x2){v1[0], v1[1]}), d = gelu_pk((f32x2){v1[2], v1[3]});
                        v0 = (f32x4){a.x, a.y, b.x, b.y}; v1 = (f32x4){c.x, c.y, d.x, d.y}; }
                    u32x4 w; w.x = cvt_pk_bf16(v0[0], v0[1]); w.y = cvt_pk_bf16(v0[2], v0[3]); w.z = cvt_pk_bf16(v1[0], v1[1]); w.w = cvt_pk_bf16(v1[2], v1[3]);
                    *(u32x4*)(rowp + bj * HALF) = w;
                    if (st) {
                        const float e0 = bflo(w.x), e1 = bfhi(w.x), e2 = bflo(w.y), e3 = bfhi(w.y), e4 = bflo(w.z), e5 = bfhi(w.z), e6 = bflo(w.w), e7 = bfhi(w.w);
                        s += ((e0 + e1) + (e2 + e3)) + ((e4 + e5) + (e6 + e7));
                        ss += ((e0 * e0 + e1 * e1) + (e2 * e2 + e3 * e3)) + ((e4 * e4 + e5 * e5) + (e6 * e6 + e7 * e7)); }
                }
                if (st) {
                    s = sum_rowpair(s); ss = sum_rowpair(ss); s = sum_halves(s); ss = sum_halves(ss);
                    if (fq == 0) *(f32x2*)(stats + ((size_t)row * 16 + (u.pn - GOFF / BM) * 4 + wc) * 2) = (f32x2){s, ss};
                }
            }
    }
};

struct EpiOut {
    static constexpr bool PERM = true;
    const float* x; bf16_t* out; unsigned char* h8; const LAS f32x2* tab;
    __device__ __forceinline__ void hook(f32x4 (&acc)[2][2][4][2], const Unit& u, int wr, int wc, int fr, int fq) const {
        const LAS f32x2* tp = tab + u.idx * BM + wr * 64 + fr;
#pragma unroll
        for (int ai = 0; ai < 2; ++ai)
#pragma unroll
            for (int m = 0; m < 4; ++m) { const float f = tp[ai * HALF + m * 16].x;
#pragma unroll
                for (int bj = 0; bj < 2; ++bj)
#pragma unroll
                    for (int n = 0; n < 2; ++n) acc[ai][bj][m][n] = acc[ai][bj][m][n] * f; }
    }
    __device__ __forceinline__ void operator()(f32x4 (&acc)[2][2][4][2], const Unit& u, int wr, int wc, int fr, int fq) const {
        const int row0 = u.pm * BM + wr * 64 + fr, col0 = u.pn * BM + wc * 32 + 8 * fq;
        const LAS f32x2* tp = tab + u.idx * BM + wr * 64 + fr;
#pragma unroll
        for (int ai = 0; ai < 2; ++ai)
#pragma unroll
            for (int mp = 0; mp < 2; ++mp) {
                f32x4 xv[2][2][2];
#pragma unroll
                for (int mm = 0; mm < 2; ++mm) { const size_t off = (size_t)(row0 + ai * HALF + (2 * mp + mm) * 16) * DM + col0;
#pragma unroll
                    for (int bj = 0; bj < 2; ++bj) { xv[mm][bj][0] = *(const GAS f32x4*)(x + off + bj * HALF); xv[mm][bj][1] = *(const GAS f32x4*)(x + off + bj * HALF + 4); } }
#pragma unroll
                for (int mm = 0; mm < 2; ++mm) { const int m = 2 * mp + mm; const float rs = tp[ai * HALF + m * 16].y;
                    const size_t off = (size_t)(row0 + ai * HALF + m * 16) * DM + col0;
#pragma unroll
                    for (int bj = 0; bj < 2; ++bj) {
                        const f32x4 h0 = xv[mm][bj][0] + acc[ai][bj][m][0] * rs, h1 = xv[mm][bj][1] + acc[ai][bj][m][1] * rs;
                        *(GAS u32x4*)(out + off + bj * HALF) = (u32x4){cvt_pk_bf16(h0[0], h0[1]), cvt_pk_bf16(h0[2], h0[3]), cvt_pk_bf16(h1[0], h1[1]), cvt_pk_bf16(h1[2], h1[3])};
                        int w0 = __builtin_amdgcn_cvt_pk_fp8_f32(h0[0], h0[1], 0, false); w0 = __builtin_amdgcn_cvt_pk_fp8_f32(h0[2], h0[3], w0, true);
                        int w1 = __builtin_amdgcn_cvt_pk_fp8_f32(h1[0], h1[1], 0, false); w1 = __builtin_amdgcn_cvt_pk_fp8_f32(h1[2], h1[3], w1, true);
                        *(GAS u32x2*)(h8 + off + bj * HALF) = (u32x2){(unsigned)w0, (unsigned)w1};
                    } }
            }
    }
};
template <class Sched>
__device__ __forceinline__ void p3_rowtab(LAS f32x2* tab, const Sched& S, const float* ass, const float* sss, int maxu) {
    Unit u;
    for (int i = 0; i < maxu && S.next(i, u); ++i) {
        if (threadIdx.x < BM) {
            const int row = u.pm * BM + threadIdx.x;
            const GAS f32x4* ap = (const GAS f32x4*)(ass + (size_t)row * 16); const GAS f32x4* sp = (const GAS f32x4*)(sss + (size_t)row * 32);
            const f32x4 sa = (ap[0] + ap[1]) + (ap[2] + ap[3]);
            const f32x4 s1 = (sp[0] + sp[1]) + (sp[2] + sp[3]), s2 = (sp[4] + sp[5]) + (sp[6] + sp[7]);
            const float A = (sa[0] + sa[1]) + (sa[2] + sa[3]), Sx = ((s1[0] + s1[1]) + (s1[2] + s1[3])) + ((s2[0] + s2[1]) + (s2[2] + s2[3]));
            const float ra = rsqrtf(A * (1.f / 1024.f) + EPS), rs = rsqrtf(Sx * (1.f / 1024.f) + EPS);
            tab[i * BM + threadIdx.x] = (f32x2){ra / rs, rs};
        }
    }
    __syncthreads();
}
}
__device__ __forceinline__ void p0_transpose_item(const float* W, int K, int N, bf16_t* WT, const float* gk, LAS float* scr, int item, int lane) {
    const int nblk = N / 64, kb = item / nblk, nb = item % nblk, k0 = 64 * kb, n0 = 64 * nb;
    const int lr = lane >> 4, lc = (lane & 15) * 4;
    f32x4 v[16];
    const float* src = W + (size_t)(k0 + lr) * N + n0 + lc;
#pragma unroll
    for (int i = 0; i < 16; ++i) v[i] = *(const GAS f32x4*)(src + (size_t)(4 * i) * N);
    if (gk) {
#pragma unroll
        for (int i = 0; i < 16; ++i) { const float g = gk[k0 + 4 * i + lr]; v[i] = v[i] * g; }
    }
#pragma unroll
    for (int i = 0; i < 16; ++i) { LAS float* d = scr + (4 * i + lr) * 65 + lc; d[0] = v[i].x; d[1] = v[i].y; d[2] = v[i].z; d[3] = v[i].w; }
    LDS_WAIT(); asm volatile("" ::: "memory");
    const int c = lane & 7;
#pragma unroll
    for (int j = 0; j < 8; ++j) { const int n = (lane >> 3) + 8 * j; const LAS float* s = scr + (8 * c) * 65 + n;
        u32x4 o; o.x = cvt_pk_bf16(s[0 * 65], s[1 * 65]); o.y = cvt_pk_bf16(s[2 * 65], s[3 * 65]); o.z = cvt_pk_bf16(s[4 * 65], s[5 * 65]); o.w = cvt_pk_bf16(s[6 * 65], s[7 * 65]);
        *(GAS u32x4*)(WT + (size_t)(n0 + n) * K + k0 + 8 * c) = o; }
    LDS_WAIT(); asm volatile("" ::: "memory");
}

constexpr int MOE_ITEMS_GU = (DM / 128) * (2 * DFF / 32), MOE_ITEMS_DN = (DFF / 128) * (DM / 32), MOE_ITEMS_E = MOE_ITEMS_GU + MOE_ITEMS_DN;
struct TrItem { const float* W; unsigned char* WT; const float* gk; int K, N, k0, n0, sw; };
__device__ __forceinline__ TrItem moe_item(const Args& a, int it) {
    TrItem t; const int e = it / MOE_ITEMS_E, q = it % MOE_ITEMS_E;
    if (q < MOE_ITEMS_GU) { t.W = a.in[17] + (size_t)e * DM * 2 * DFF; t.WT = a.ws + WS_WGU + (size_t)e * 2 * DFF * DM; t.gk = a.in[14]; t.sw = 1; t.K = DM; t.N = 2 * DFF; const int nblk = 2 * DFF / 32; t.k0 = 128 * (q / nblk); t.n0 = 32 * (q % nblk); }
    else { const int r = q - MOE_ITEMS_GU; t.W = a.in[19] + (size_t)e * DFF * DM; t.WT = a.ws + WS_WDN + (size_t)e * DM * DFF; t.gk = nullptr; t.sw = 0; t.K = DFF; t.N = DM; const int nblk = DM / 32; t.k0 = 128 * (r / nblk); t.n0 = 32 * (r % nblk); }
    return t;
}
__device__ __forceinline__ void tr8_load(const TrItem& t, int lane, f32x4 (&v)[16]) {
    const int lr = lane >> 3, lc = (lane & 7) * 4;
    const float* src = t.W + (size_t)(t.k0 + lr) * t.N + t.n0 + lc;
#pragma unroll
    for (int i = 0; i < 16; ++i) v[i] = __builtin_nontemporal_load((const f32x4*)(src + (size_t)(8 * i) * t.N));
}
__device__ __forceinline__ void tr8_store(const TrItem& t, int lane, f32x4 (&v)[16], LAS float* scr, const float (&gs)[8]) {
    const int lr = lane >> 3, lc = (lane & 7) * 4;
#pragma unroll
    for (int i = 0; i < 16; ++i) { LAS float* d = scr + (8 * i + lr) * 33 + lc; d[0] = v[i].x; d[1] = v[i].y; d[2] = v[i].z; d[3] = v[i].w; }
    LDS_WAIT(); asm volatile("" ::: "memory");
    const int c = lane >> 2, nl = lane & 3, no = t.sw ? (nl ^ (((nl ^ (nl >> 1)) & 1) * 3)) : nl;
#pragma unroll
    for (int j = 0; j < 8; ++j) { const int n = nl + 4 * j; const LAS float* s = scr + (8 * c) * 33 + n;
        int w0 = __builtin_amdgcn_cvt_pk_fp8_f32(s[0 * 33] * gs[0], s[1 * 33] * gs[1], 0, false); w0 = __builtin_amdgcn_cvt_pk_fp8_f32(s[2 * 33] * gs[2], s[3 * 33] * gs[3], w0, true);
        int w1 = __builtin_amdgcn_cvt_pk_fp8_f32(s[4 * 33] * gs[4], s[5 * 33] * gs[5], 0, false); w1 = __builtin_amdgcn_cvt_pk_fp8_f32(s[6 * 33] * gs[6], s[7 * 33] * gs[7], w1, true);
        __builtin_nontemporal_store((u32x2){(unsigned)w0, (unsigned)w1}, (u32x2*)(t.WT + (size_t)(t.n0 + 4 * j + no) * t.K + t.k0 + 8 * c)); }
    LDS_WAIT(); asm volatile("" ::: "memory");
}
constexpr int MOE_NSLICE = NE * MOE_ITEMS_E / 8;
struct TrSet { f32x4 v[16]; f32x4 g0, g1; TrItem t; };
__device__ __forceinline__ void moe_load_item(const Args& a, int item, int lane, TrSet& s) {
    s.t = moe_item(a, item);
    tr8_load(s.t, lane, s.v);
    if (s.t.gk) { s.g0 = *(const GAS f32x4*)(s.t.gk + s.t.k0 + 8 * (lane >> 2)); s.g1 = *(const GAS f32x4*)(s.t.gk + s.t.k0 + 8 * (lane >> 2) + 4); }
    else { s.g0 = (f32x4){1.f, 1.f, 1.f, 1.f}; s.g1 = s.g0; }
}
__device__ __forceinline__ void moe_store_item(Frame& F, TrSet& s) {
    LAS float* scr = (LAS float*)(F.lds + F.wave * 16896);
    float gs[8];
#pragma unroll
    for (int q = 0; q < 4; ++q) { gs[q] = s.g0[q] * 64.f; gs[4 + q] = s.g1[q] * 64.f; }
    tr8_store(s.t, F.lane, s.v, scr, gs);
}
__device__ __forceinline__ void moe_convert_pull(Frame& F, const Args& a, int maxn = 0x7fffffff) {
    volatile LAS int* slot = (volatile LAS int*)(F.MISC + 16);
    unsigned* qh = F.ctl + CW_QHEAD;
    __syncthreads(); if (F.tid == 0) slot[0] = (int)xb_add(qh, 2u); __syncthreads();
    int cur = slot[0], nxt = cur + 1, claims = 2;
    TrSet s0, s1;
    if (cur < MOE_NSLICE) moe_load_item(a, cur * 8 + F.wave, F.lane, s0);
#define MOE_STEP(SA, SB) do { \
        __syncthreads();                                  \
        unsigned nn_ = (unsigned)MOE_NSLICE; \
        if (F.tid == 0 && claims < maxn) nn_ = xb_add(qh, 1u); \
        ++claims; \
        if (nxt < MOE_NSLICE) moe_load_item(a, nxt * 8 + F.wave, F.lane, SB); \
        moe_store_item(F, SA); \
        if (F.tid == 0) slot[0] = (int)nn_; \
        __syncthreads(); \
        cur = nxt; nxt = slot[0]; } while (0)
    for (;;) {
        if (cur >= MOE_NSLICE) break;
        MOE_STEP(s0, s1);
        if (cur >= MOE_NSLICE) break;
        MOE_STEP(s1, s0);
    }
#undef MOE_STEP
}

__device__ __forceinline__ void p0_prologue(Frame& F, const Args& a) {
    unsigned char* ws = a.ws;
    LAS float* scr = (LAS float*)(F.lds + F.wave * 16896);
    const int gw = F.vcu * NWAVES + F.wave, NGW = F.G * NWAVES;
    constexpr int I_IN = (DM / 64) * (DIN / 64), I_OUT = (DM / 64) * (DM / 64), I_PG = I_OUT, I_PLE = (DPLE / 64) * (DM / 64);
    const int NITEMS = I_IN + I_OUT + I_PG + I_PLE;
    for (int it = gw; it < NITEMS; it += NGW) {
        int r = it;
        if (r < I_IN) { p0_transpose_item(a.in[3], DM, DIN, (bf16_t*)(ws + WS_WIN), a.in[2], scr, r, F.lane); continue; } r -= I_IN;
        if (r < I_OUT) { const int kb = r / (DM / 64); p0_transpose_item(a.in[13], DM, DM, (bf16_t*)(ws + WS_WOUT), kb < 16 ? a.in[11] : a.in[12] - DATT, scr, r, F.lane); continue; } r -= I_OUT;
        if (r < I_PG) {
            TrItem t; t.W = a.in[23]; t.WT = ws + WS_WPG; t.gk = a.in[22]; t.sw = 0; t.K = DM; t.N = DM; t.k0 = 128 * (r / (DM / 32)); t.n0 = 32 * (r % (DM / 32));
            f32x4 v[16]; tr8_load(t, F.lane, v);
            const f32x4 g0 = *(const GAS f32x4*)(t.gk + t.k0 + 8 * (F.lane >> 2)), g1 = *(const GAS f32x4*)(t.gk + t.k0 + 8 * (F.lane >> 2) + 4);
            float gs[8];
#pragma unroll
            for (int q = 0; q < 4; ++q) { gs[q] = g0[q] * 64.f; gs[4 + q] = g1[q] * 64.f; }
            tr8_store(t, F.lane, v, scr, gs); continue; } r -= I_PG;
        p0_transpose_item(a.in[21], DPLE, DM, (bf16_t*)(ws + WS_WPLE), nullptr, scr, r, F.lane);
    }
    const float* x = a.in[0];
    for (int m = gw; m < T; m += NGW) {
        const GAS f32x4* xr = (const GAS f32x4*)(x + (size_t)m * DM) + F.lane;
        f32x4 v[8]; float s = 0.f;
#pragma unroll
        for (int j = 0; j < 8; ++j) { v[j] = __builtin_nontemporal_load((const f32x4*)(x + (size_t)m * DM) + 64 * j + F.lane); s += (v[j].x * v[j].x + v[j].y * v[j].y) + (v[j].z * v[j].z + v[j].w * v[j].w); }
        const float rs = rsqrtf(wave_sum(s) * (1.f / DM) + EPS);
        GAS u32x2* o = (GAS u32x2*)((bf16_t*)(ws + WS_XB) + (size_t)m * DM) + F.lane;
#pragma unroll
        for (int j = 0; j < 8; ++j) o[64 * j] = (u32x2){cvt_pk_bf16(v[j].x * rs, v[j].y * rs), cvt_pk_bf16(v[j].z * rs, v[j].w * rs)};
    }
    {
        const GAS f32x4* pr = (const GAS f32x4*)a.in[1]; GAS u32x2* po = (GAS u32x2*)(ws + WS_PB);
        for (int i = (F.vcu * NWAVES * 64) + F.tid; i < T * DPLE / 4; i += F.G * NWAVES * 64) { const f32x4 v = pr[i]; po[i] = (u32x2){cvt_pk_bf16(v.x, v.y), cvt_pk_bf16(v.z, v.w)}; }
    }
    {
        const float* wsrc = a.in[9]; bf16_t* wd = (bf16_t*)(ws + WS_WSP);
        for (int i = (F.vcu * NWAVES * 64) + F.tid; i < NSG * SGC * SGC / 2; i += F.G * NWAVES * 64) {
            const int e0 = 2 * i, t = (e0 >> 7) & 127, s0 = e0 & 127;
            const float a0 = (s0 <= t) ? wsrc[e0] : 0.f, a1 = (s0 + 1 <= t) ? wsrc[e0 + 1] : 0.f;
            ((unsigned*)wd)[i] = cvt_pk_bf16(a0, a1); }
        const float* wr = a.in[15]; const float* g2 = a.in[14]; float* wo = (float*)(ws + WS_WR);
        for (int i = (F.vcu * NWAVES * 64) + F.tid; i < DM * NE; i += F.G * NWAVES * 64) wo[i] = wr[i] * g2[i >> 5];
    }
}
typedef short v4i16_t __attribute__((ext_vector_type(4)));
typedef short s16x4 __attribute__((ext_vector_type(4)));
__device__ __forceinline__ s16x4 ds_tr16(LAS const unsigned char* p) { return __builtin_bit_cast(s16x4, __builtin_amdgcn_ds_read_tr16_b64_v4i16((LAS v4i16_t*)p)); }
__device__ __forceinline__ bf16x8 cat48(s16x4 a, s16x4 b) { bf16x8 r; r[0] = a[0]; r[1] = a[1]; r[2] = a[2]; r[3] = a[3]; r[4] = b[0]; r[5] = b[1]; r[6] = b[2]; r[7] = b[3]; return r; }
__device__ __forceinline__ bf16x8 pack8(float a0, float a1, float a2, float a3, float a4, float a5, float a6, float a7) {
    u32x4 w; w.x = cvt_pk_bf16(a0, a1); w.y = cvt_pk_bf16(a2, a3); w.z = cvt_pk_bf16(a4, a5); w.w = cvt_pk_bf16(a6, a7); return __builtin_bit_cast(bf16x8, w); }

constexpr float LOG2E = 1.4426950408889634f;
constexpr int ATT_K_OFF = 0, ATT_V_OFF = 32768, ATT_O_OFF = 65536;
__device__ __forceinline__ int k_img(int row, int ch) { return row * 128 + ((ch ^ (row & 7)) << 4); }
__device__ __forceinline__ int v_img(int row, int ch) { return row * 128 + ((ch ^ (((row >> 1) & 1) << 2)) << 4); }
__device__ __forceinline__ int sv_img(int row, int ch) { return row * 256 + ((ch ^ ((row & 3) << 2)) << 4); }

struct AttConst { f32x4 kg[2], qg[8]; };
__device__ __forceinline__ void attn_consts(Frame& F, const Args& a, AttConst& C) {
    const int ch = F.tid & 7, hh = F.lane >> 5;
    C.kg[0] = *(const GAS f32x4*)(a.in[5] + ch * 8); C.kg[1] = *(const GAS f32x4*)(a.in[5] + ch * 8 + 4);
#pragma unroll
    for (int i = 0; i < 8; ++i) C.qg[i] = *(const GAS f32x4*)(a.in[4] + 16 * (i >> 1) + 8 * hh + 4 * (i & 1));
}
__device__ __forceinline__ void attn_unit(Frame& F, const Args& a, int unit, const AttConst& C) {
    unsigned char* ws = a.ws;
    const bf16_t* proj = (const bf16_t*)(ws + WS_PROJ);
    const int n = unit >> 2, kvh = unit & 3;
    LAS unsigned char* lds = F.lds;
    __syncthreads();
    {
        const int ch = F.tid & 7;
        u32x4 kv[4], vv[4];
#pragma unroll
        for (int i = 0; i < 4; ++i) {
            const int kabs = (n - 1) * 128 + 64 * i + (F.tid >> 3);
            if (kabs >= 0) { kv[i] = *(const GAS u32x4*)(proj + (size_t)kabs * DIN + KOFF + kvh * 64 + ch * 8); vv[i] = *(const GAS u32x4*)(proj + (size_t)kabs * DIN + VOFF + kvh * 64 + ch * 8); }
            else { kv[i] = (u32x4){0u, 0u, 0u, 0u}; vv[i] = (u32x4){0u, 0u, 0u, 0u}; }
        }
#pragma unroll
        for (int i = 0; i < 4; ++i) {
            const int row = 64 * i + (F.tid >> 3);
            float ss = 0.f;
#pragma unroll
            for (int e = 0; e < 4; ++e) { const float lo = bflo(kv[i][e]), hi = bfhi(kv[i][e]); ss += lo * lo + hi * hi; }
            ss = sum8(ss);
            const float rs = rsqrtf(ss * (1.f / 64.f) + EPS);
            u32x4 w;
#pragma unroll
            for (int e = 0; e < 4; ++e) w[e] = cvt_pk_bf16(bflo(kv[i][e]) * rs * C.kg[e >> 1][2 * (e & 1)], bfhi(kv[i][e]) * rs * C.kg[e >> 1][2 * (e & 1) + 1]);
            *(LAS u32x4*)(lds + ATT_K_OFF + k_img(row, ch)) = w;
            *(LAS u32x4*)(lds + ATT_V_OFF + v_img(row, ch)) = vv[i];
        }
    }
    __syncthreads();
    const int g = F.wave >> 1, h = kvh * 4 + g, l31 = F.lane & 31, hh = F.lane >> 5;
    const float sink2 = a.in[6][h] * LOG2E;
    bf16_t* mg = (bf16_t*)(ws + WS_MG);
    float* ass = (float*)(ws + WS_ASS);
#pragma unroll 1
    for (int qb = 0; qb < 2; ++qb) {
        const int r0 = (F.wave & 1) * 64 + qb * 32, qi = r0 + l31, qabs = n * 128 + qi;
        bf16x8 qf[4];
        {
            const GAS u32x4* qp = (const GAS u32x4*)(proj + (size_t)qabs * DIN + QOFF + h * 64 + 8 * hh);
            u32x4 qv[4]; float ss = 0.f;
#pragma unroll
            for (int s = 0; s < 4; ++s) { qv[s] = qp[2 * s];
#pragma unroll
                for (int e = 0; e < 4; ++e) { const float lo = bflo(qv[s][e]), hi = bfhi(qv[s][e]); ss += lo * lo + hi * hi; } }
            ss = sum_halves(ss);
            const float rs = rsqrtf(ss * (1.f / 64.f) + EPS) * (0.125f * LOG2E);
#pragma unroll
            for (int s = 0; s < 4; ++s) { u32x4 w;
#pragma unroll
                for (int e = 0; e < 4; ++e) w[e] = cvt_pk_bf16(bflo(qv[s][e]) * rs * C.qg[2 * s + (e >> 1)][2 * (e & 1)], bfhi(qv[s][e]) * rs * C.qg[2 * s + (e >> 1)][2 * (e & 1) + 1]);
                qf[s] = __builtin_bit_cast(bf16x8, w); }
        }
        const int kb0 = r0 >> 5;
        f32x16 st[5];
#pragma unroll
        for (int j = 0; j < 5; ++j) {
            st[j] = (f32x16){0.f, 0.f, 0.f, 0.f, 0.f, 0.f, 0.f, 0.f, 0.f, 0.f, 0.f, 0.f, 0.f, 0.f, 0.f, 0.f};
            const int krow = 32 * (kb0 + j) + l31;
#pragma unroll
            for (int s = 0; s < 4; ++s) {
                const bf16x8 kf = *(const LAS bf16x8*)(lds + ATT_K_OFF + k_img(krow, 2 * s + hh));
                st[j] = __builtin_amdgcn_mfma_f32_32x32x16_bf16(kf, qf[s], st[j], 0, 0, 0);
            }
        }
        const int lo = (n == 0) ? 128 : qi + 1, hi = qi + 128;
        float m = sink2;
#pragma unroll
        for (int j = 0; j < 5; ++j)
#pragma unroll
            for (int r = 0; r < 16; ++r) { const int sj = 32 * (kb0 + j) + (r & 3) + 8 * (r >> 2) + 4 * hh; const bool ok = (sj >= lo) && (sj <= hi);
                st[j][r] = ok ? st[j][r] : -3.0e38f; m = fmaxf(m, st[j][r]); }
        { const f32x2 mh = halves_f(m); m = fmaxf(mh.x, mh.y); }
        float lsum = 0.f;
#pragma unroll
        for (int j = 0; j < 5; ++j)
#pragma unroll
            for (int r = 0; r < 16; ++r) { const float p = __builtin_amdgcn_exp2f(st[j][r] - m); st[j][r] = p; lsum += p; }
        lsum = sum_halves(lsum);
        lsum += __builtin_amdgcn_exp2f(sink2 - m);
        const float inv = 1.f / lsum;
        f32x16 o[2];
        o[0] = (f32x16){0.f, 0.f, 0.f, 0.f, 0.f, 0.f, 0.f, 0.f, 0.f, 0.f, 0.f, 0.f, 0.f, 0.f, 0.f, 0.f}; o[1] = o[0];
        const int li = F.lane & 15, lg = (F.lane >> 4) & 1;
#pragma unroll
        for (int j = 0; j < 5; ++j)
#pragma unroll
            for (int s = 0; s < 2; ++s) {
                const bf16x8 pf = pack8(st[j][8 * s + 0], st[j][8 * s + 1], st[j][8 * s + 2], st[j][8 * s + 3], st[j][8 * s + 4], st[j][8 * s + 5], st[j][8 * s + 6], st[j][8 * s + 7]);
                const int kbase = 32 * (kb0 + j) + 16 * s + 4 * hh + (li >> 2);
#pragma unroll
                for (int db = 0; db < 2; ++db) {
                    const int col = 32 * db + 16 * lg + 4 * (li & 3);
                    const s16x4 v0 = ds_tr16(lds + ATT_V_OFF + v_img(kbase, col >> 3) + (col & 7) * 2);
                    const s16x4 v1 = ds_tr16(lds + ATT_V_OFF + v_img(kbase + 8, col >> 3) + (col & 7) * 2);
                    o[db] = __builtin_amdgcn_mfma_f32_32x32x16_bf16(cat48(v0, v1), pf, o[db], 0, 0, 0);
                }
            }
        float ssq = 0.f;
        LAS unsigned char* ob = lds + ATT_O_OFF + F.wave * 4096;
#pragma unroll
        for (int db = 0; db < 2; ++db)
#pragma unroll
            for (int rq = 0; rq < 4; ++rq) {
                u32x2 w; w.x = cvt_pk_bf16(o[db][4 * rq] * inv, o[db][4 * rq + 1] * inv); w.y = cvt_pk_bf16(o[db][4 * rq + 2] * inv, o[db][4 * rq + 3] * inv);
                *(LAS u32x2*)(ob + l31 * 128 + (((4 * db + rq) ^ (l31 & 7)) << 4) + 8 * hh) = w;
                const float e0 = bflo(w.x), e1 = bfhi(w.x), e2 = bflo(w.y), e3 = bfhi(w.y);
                ssq += (e0 * e0 + e1 * e1) + (e2 * e2 + e3 * e3);
            }
        ssq = sum_halves(ssq);
        if (hh == 0) ass[(size_t)qabs * 16 + h] = ssq;
#pragma unroll
        for (int pp = 0; pp < 4; ++pp) {
            const int row = 8 * pp + (F.lane >> 3), chn = F.lane & 7;
            const u32x4 w = *(const LAS u32x4*)(ob + row * 128 + ((chn ^ (row & 7)) << 4));
            *(GAS u32x4*)(mg + (size_t)(n * 128 + r0 + row) * DM + h * 64 + chn * 8) = w;
        }
    }
}

struct SgStage { u32x4 v[4]; f32x2 st[4]; };
__device__ __forceinline__ void sg_prefetch(Frame& F, const Args& a, int unit, SgStage& S) {
    unsigned char* ws = a.ws;
    const bf16_t* proj = (const bf16_t*)(ws + WS_PROJ);
    const int nc = unit >> 3, g = unit & 7, s = F.tid >> 2, qt = F.tid & 3;
    const size_t row = (size_t)nc * 128 + s;
    const GAS f32x2* sp = (const GAS f32x2*)(ws + WS_STATS) + row * 16 + qt * 4;
    const GAS u32x4* vp = (const GAS u32x4*)(proj + row * DIN + GOFF + g * 128) + qt;
#pragma unroll
    for (int j = 0; j < 4; ++j) { S.st[j] = sp[j]; S.v[j] = vp[4 * j]; }
}
struct SgConst { bf16x8 wf[2][8]; f32x4 gl[8], bl[8]; float btv[2]; int g; };
__device__ __forceinline__ void sg_consts(Frame& F, const Args& a, int g, SgConst& C) {
    const int qt0 = F.tid & 3, l31 = F.lane & 31, hh = F.lane >> 5;
    const GAS f32x4* lgp0 = (const GAS f32x4*)(a.in[7] + g * 128 + qt0 * 8); const GAS f32x4* lbp0 = (const GAS f32x4*)(a.in[8] + g * 128 + qt0 * 8);
#pragma unroll
    for (int j = 0; j < 8; ++j) { C.gl[j] = lgp0[8 * (j >> 1) + (j & 1)]; C.bl[j] = lbp0[8 * (j >> 1) + (j & 1)]; }
    const bf16_t* wsp = (const bf16_t*)(a.ws + WS_WSP) + (size_t)g * 128 * 128;
    const float* bsp = a.in[10] + g * 128;
#pragma unroll
    for (int ti = 0; ti < 2; ++ti) { const int t = 32 * (2 * (F.wave >> 2) + ti) + l31;
#pragma unroll
        for (int ks = 0; ks < 8; ++ks) C.wf[ti][ks] = *(const GAS bf16x8*)(wsp + (size_t)t * 128 + 16 * ks + 8 * hh);
        C.btv[ti] = bsp[t]; }
    C.g = g;
}
__device__ __forceinline__ void sg_unit(Frame& F, const Args& a, int unit, SgStage& S, int next_unit, SgConst& C) {
    unsigned char* ws = a.ws;
    const bf16_t* proj = (const bf16_t*)(ws + WS_PROJ);
    const int nc = unit >> 3, g = unit & 7;
    LAS unsigned char* lds = F.lds;
    if (C.g != g) sg_consts(F, a, g, C);
    __syncthreads();
    {
        const int s = F.tid >> 2, qt = F.tid & 3;
        float Sx = 0.f, SS = 0.f;
#pragma unroll
        for (int j = 0; j < 4; ++j) { Sx += S.st[j].x; SS += S.st[j].y; }
        Sx += dpp_f<DPP_X1>(Sx); SS += dpp_f<DPP_X1>(SS); Sx += dpp_f<DPP_X2>(Sx); SS += dpp_f<DPP_X2>(SS);
        const float mu = Sx * (1.f / 1024.f), var = SS * (1.f / 1024.f) - mu * mu, rs = rsqrtf(fmaxf(var, 0.f) + EPS);
#pragma unroll
        for (int j = 0; j < 4; ++j) { const u32x4 v = S.v[j]; const f32x4 g0 = C.gl[2 * j], g1 = C.gl[2 * j + 1], b0 = C.bl[2 * j], b1 = C.bl[2 * j + 1]; u32x4 w;
            w.x = cvt_pk_bf16((bflo(v.x) - mu) * rs * g0[0] + b0[0], (bfhi(v.x) - mu) * rs * g0[1] + b0[1]);
            w.y = cvt_pk_bf16((bflo(v.y) - mu) * rs * g0[2] + b0[2], (bfhi(v.y) - mu) * rs * g0[3] + b0[3]);
            w.z = cvt_pk_bf16((bflo(v.z) - mu) * rs * g1[0] + b1[0], (bfhi(v.z) - mu) * rs * g1[1] + b1[1]);
            w.w = cvt_pk_bf16((bflo(v.w) - mu) * rs * g1[2] + b1[2], (bfhi(v.w) - mu) * rs * g1[3] + b1[3]);
            *(LAS u32x4*)(lds + sv_img(s, qt + 4 * j)) = w; }
    }
    if (next_unit >= 0) sg_prefetch(F, a, next_unit, S);
    __syncthreads();
    const int cb = F.wave & 3, l31 = F.lane & 31, hh = F.lane >> 5, li = F.lane & 15, lg = (F.lane >> 4) & 1;
    bf16_t* mg = (bf16_t*)(ws + WS_MG);
    float* sss = (float*)(ws + WS_SSS);
    const int col = 32 * cb + 16 * lg + 4 * (li & 3);
    u32x2 uvv[2][4];
#pragma unroll
    for (int ti = 0; ti < 2; ++ti) { const int t = 32 * (2 * (F.wave >> 2) + ti) + l31; const size_t tabs = (size_t)nc * 128 + t;
#pragma unroll
        for (int rq = 0; rq < 4; ++rq) uvv[ti][rq] = *(const GAS u32x2*)(proj + tabs * DIN + UOFF + g * 128 + 32 * cb + 4 * hh + 8 * rq); }
#pragma unroll
    for (int ti = 0; ti < 2; ++ti) {
        const int tb = 2 * (F.wave >> 2) + ti, t = 32 * tb + l31;
        f32x16 acc = (f32x16){0.f, 0.f, 0.f, 0.f, 0.f, 0.f, 0.f, 0.f, 0.f, 0.f, 0.f, 0.f, 0.f, 0.f, 0.f, 0.f};
        const int nks = 2 * tb + 2;
#pragma unroll
        for (int ks = 0; ks < 8; ++ks) {
            if (ks < nks) {
                const int kbase = 16 * ks + 8 * hh + (li >> 2);
                const s16x4 v0 = ds_tr16(lds + sv_img(kbase, col >> 3) + (col & 7) * 2);
                const s16x4 v1 = ds_tr16(lds + sv_img(kbase + 4, col >> 3) + (col & 7) * 2);
                acc = __builtin_amdgcn_mfma_f32_32x32x16_bf16(cat48(v0, v1), C.wf[ti][ks], acc, 0, 0, 0);
            }
        }
        const size_t tabs = (size_t)nc * 128 + t;
        const float bt = C.btv[ti];
        bf16_t* orow = mg + tabs * DM + DATT + g * 128 + 32 * cb + 4 * hh;
        float ssq = 0.f;
#pragma unroll
        for (int rq = 0; rq < 4; ++rq) {
            const u32x2 uv = uvv[ti][rq];
            u32x2 w; w.x = cvt_pk_bf16(bflo(uv.x) * (acc[4 * rq] + bt), bfhi(uv.x) * (acc[4 * rq + 1] + bt)); w.y = cvt_pk_bf16(bflo(uv.y) * (acc[4 * rq + 2] + bt), bfhi(uv.y) * (acc[4 * rq + 3] + bt));
            *(GAS u32x2*)(orow + 8 * rq) = w;
            const float e0 = bflo(w.x), e1 = bfhi(w.x), e2 = bflo(w.y), e3 = bfhi(w.y);
            ssq += (e0 * e0 + e1 * e1) + (e2 * e2 + e3 * e3);
        }
        ssq = sum_halves(ssq);
        if (hh == 0) sss[tabs * 32 + g * 4 + cb] = ssq;
    }
}

__device__ __forceinline__ void p2_mixers(Frame& F, const Args& a) {
    if (F.cvcu < (T / 128) * NKVH) { AttConst AC; attn_consts(F, a, AC);
        for (int u = F.cvcu; u < (T / 128) * NKVH; u += F.cG) attn_unit(F, a, u, AC); }
    {
        SgStage S; SgConst C; C.g = -1; const int nsg = (T / 128) * NSG, nat = (T / 128) * NKVH;
        const bool bal = (F.cG == 152 && nsg == 512 && nat == 256);
        const int r1 = F.cvcu - (nat - F.cG);
        auto unit_at = [&](int k) -> int {
            if (!bal) { const int u = F.cvcu + k * F.cG; return u < nsg ? u : -1; }
            if (k < 3) return F.cvcu + k * F.cG;
            if (r1 < 0) return -1;
            if (k == 3) return 3 * F.cG + r1;
            if (k == 4 && r1 < nsg - 3 * F.cG - (2 * F.cG - nat)) return 3 * F.cG + (2 * F.cG - nat) + r1;
            return -1; };
        int u = unit_at(0);
        if (u >= 0) sg_prefetch(F, a, u, S);
        for (int k = 0; u >= 0; ++k) { const int nx = unit_at(k + 1); sg_unit(F, a, u, S, nx, C); u = nx; }
    }
}
constexpr int RT_W = 0, RT_H = 65536, RT_TPW = 8;
__device__ __forceinline__ void p4_router(Frame& F, const Args& a) {
    unsigned char* ws = a.ws;
    const bf16_t* h = (const bf16_t*)(ws + WS_HF);
    const float* wr = (const float*)(ws + WS_WR);
    const float* br = a.in[16];
    int* cnt = (int*)(F.ctl + CW_CNT);
    int* row_tok = (int*)(ws + WS_ROWTOK); float* row_rs = (float*)(ws + WS_ROWRS);
    int* tokinfo = (int*)(ws + WS_TOKINFO); float* tokgate = (float*)(ws + WS_TOKINFO + 131072);
    const int eg = F.lane & 7, kq = F.lane >> 3;
    for (int grp = F.cvcu; grp < T / (8 * RT_TPW); grp += F.cG) {
        const int tok0 = grp * (8 * RT_TPW) + F.wave * RT_TPW;
        f32x4 acc[RT_TPW]; float ssq[RT_TPW];
#pragma unroll
        for (int t = 0; t < RT_TPW; ++t) { acc[t] = (f32x4){0.f, 0.f, 0.f, 0.f}; ssq[t] = 0.f; }
        f32x4 wv[4]; u32x2 hr[RT_TPW];
        const GAS f32x4* wsrc = (const GAS f32x4*)wr + F.tid;
        const GAS u32x2* hsrc = (const GAS u32x2*)(h + (size_t)tok0 * DM) + F.lane;
        __syncthreads();
#pragma unroll
        for (int i = 0; i < 4; ++i) wv[i] = wsrc[i * 512];
#pragma unroll
        for (int t = 0; t < RT_TPW; ++t) hr[t] = hsrc[(size_t)t * (DM / 4)];
        LAS f32x4* hs = (LAS f32x4*)(F.lds + RT_H + F.wave * 8192);
#pragma unroll 1
        for (int c = 0; c < 8; ++c) {
            LAS f32x4* Wl = (LAS f32x4*)(F.lds + RT_W + (c & 1) * 32768);
#pragma unroll
            for (int i = 0; i < 4; ++i) Wl[F.tid + i * 512] = wv[i];
            f32x4 hv4[RT_TPW];
#pragma unroll
            for (int t = 0; t < RT_TPW; ++t) { hv4[t] = (f32x4){bflo(hr[t].x), bfhi(hr[t].x), bflo(hr[t].y), bfhi(hr[t].y)};
                ssq[t] += (hv4[t].x * hv4[t].x + hv4[t].y * hv4[t].y) + (hv4[t].z * hv4[t].z + hv4[t].w * hv4[t].w); }
#pragma unroll
            for (int cc = 0; cc < 4; ++cc) { hs[2 * (cc * 64 + F.lane)] = (f32x4){hv4[0][cc], hv4[1][cc], hv4[2][cc], hv4[3][cc]};
                hs[2 * (cc * 64 + F.lane) + 1] = (f32x4){hv4[4][cc], hv4[5][cc], hv4[6][cc], hv4[7][cc]}; }
            if (c < 7) {
#pragma unroll
                for (int i = 0; i < 4; ++i) wv[i] = wsrc[(c + 1) * 2048 + i * 512];
#pragma unroll
                for (int t = 0; t < RT_TPW; ++t) hr[t] = hsrc[(size_t)t * (DM / 4) + (c + 1) * 64];
            }
            __syncthreads();
#pragma unroll 1
            for (int kb = 0; kb < 32; kb += 4) {
                f32x4 w[4], ha[4], hb[4];
#pragma unroll
                for (int q = 0; q < 4; ++q) { const int k = 8 * (kb + q) + kq, p = 2 * ((k & 3) * 64 + (k >> 2)); w[q] = Wl[k * 8 + eg]; ha[q] = hs[p]; hb[q] = hs[p + 1]; }
#pragma unroll
                for (int q = 0; q < 4; ++q)
#pragma unroll
                    for (int t = 0; t < 4; ++t) { acc[t] = acc[t] + w[q] * ha[q][t]; acc[4 + t] = acc[4 + t] + w[q] * hb[q][t]; }
            }
        }
        const f32x4 be = *(const GAS f32x4*)(br + 4 * eg);
        f32x4 cand[RT_TPW];
#pragma unroll
        for (int t = 0; t < RT_TPW; ++t) { const float rs = rsqrtf(wave_sum(ssq[t]) * (1.f / DM) + EPS); ssq[t] = rs;
#pragma unroll
            for (int i = 0; i < 4; ++i) { float s = acc[t][i]; s += dpp_f<DPP_X8>(s); s = sum_rowpair(s); s = sum_halves(s); cand[t][i] = s * rs + be[i]; } }
        int sel_e[RT_TPW][4]; float sel_v[RT_TPW][4];
#pragma unroll
        for (int t = 0; t < RT_TPW; ++t) {
#pragma unroll
            for (int k = 0; k < 4; ++k) {
                float bv = cand[t][0]; int bi = 4 * eg;
#pragma unroll
                for (int i = 1; i < 4; ++i) if (cand[t][i] > bv) { bv = cand[t][i]; bi = 4 * eg + i; }
                { const float ov = dpp_f<DPP_X1>(bv); const int oi = dpp_i<DPP_X1>(bi); const bool take = (ov > bv) || (ov == bv && oi < bi); bv = take ? ov : bv; bi = take ? oi : bi; }
                { const float ov = dpp_f<DPP_X2>(bv); const int oi = dpp_i<DPP_X2>(bi); const bool take = (ov > bv) || (ov == bv && oi < bi); bv = take ? ov : bv; bi = take ? oi : bi; }
                { const float ov = dpp_f<DPP_HM>(bv); const int oi = dpp_i<DPP_HM>(bi); const bool take = (ov > bv) || (ov == bv && oi < bi); bv = take ? ov : bv; bi = take ? oi : bi; }
                sel_e[t][k] = bi; sel_v[t][k] = bv;
#pragma unroll
                for (int i = 0; i < 4; ++i) if (bi == 4 * eg + i) cand[t][i] = -3.0e38f;
            }
        }
        {
            LAS int* hist = (LAS int*)(F.lds + XTR_OFF);
            if (F.tid < 64) hist[F.tid] = 0;
            __syncthreads();
            const int ti = (F.lane >> 2) & 7, k = F.lane & 3;
            int me = 0; float mv = 0.f, v0 = 0.f, v1 = 0.f, v2 = 0.f, v3 = 0.f, rs = 0.f;
#pragma unroll
            for (int t = 0; t < RT_TPW; ++t) if (ti == t) { rs = ssq[t]; v0 = sel_v[t][0]; v1 = sel_v[t][1]; v2 = sel_v[t][2]; v3 = sel_v[t][3];
#pragma unroll
                for (int kk = 0; kk < 4; ++kk) if (k == kk) { me = sel_e[t][kk]; mv = sel_v[t][kk]; } }
            const float e0 = 1.f, e1 = __expf(v1 - v0), e2 = __expf(v2 - v0), e3 = __expf(v3 - v0);
            const float gate = __expf(mv - v0) / ((e0 + e1) + (e2 + e3));
            int rank = 0;
            if (F.lane < 4 * RT_TPW) rank = __hip_atomic_fetch_add(hist + me, 1, __ATOMIC_RELAXED, __HIP_MEMORY_SCOPE_WORKGROUP);
            __syncthreads();
            if (F.tid < NE) { const int c = hist[F.tid]; hist[32 + F.tid] = c ? atomicAdd(&cnt[64 * F.tid], c) : 0; }
            __syncthreads();
            if (F.lane < 4 * RT_TPW) {
                const int tok = tok0 + ti;
                const int pos = hist[32 + me] + rank;
                row_tok[me * CAP + pos] = tok; row_rs[me * CAP + pos] = rs;
                tokinfo[tok * 4 + k] = (me << 16) | pos; tokgate[tok * 4 + k] = gate;
            }
        }
    }
}

constexpr int MOE_MAXU = 12;
constexpr int XTR_GTAB = 0, XTR_ULIST = MOE_MAXU * 1024, XTR_ROWOFF = XTR_ULIST + 512;
struct MoeOrder {
    const char* A; const char* Bt; size_t estride; int rb; bool gather; const LAS int* ulist; const LAS unsigned* gtab; int nunits;
    __device__ __forceinline__ bool next(int i, pg8::Unit& u) const {
        if (i >= nunits) return false;
        const LAS int* p = ulist + 4 * i;
        u.e = __builtin_amdgcn_readfirstlane(p[0]); u.pm = __builtin_amdgcn_readfirstlane(p[1]); u.pn = __builtin_amdgcn_readfirstlane(p[2]); u.rows = __builtin_amdgcn_readfirstlane(p[3]); u.idx = i; return true;
    }
    __device__ __forceinline__ const char* a_ptr(const pg8::Unit& u) const { return gather ? A : A + (size_t)u.pm * ((size_t)pg8::HALF * rb); }
    __device__ __forceinline__ const char* b_ptr(const pg8::Unit& u) const { return Bt + (size_t)u.e * estride + (size_t)u.pn * ((size_t)pg8::BM * rb); }
    __device__ __forceinline__ unsigned gather_off(int ui, int r) const { return gtab[ui * 256 + r]; }
};
__device__ __forceinline__ int moe_build(Frame& F, const Args& a, int nN_, bool gather, int nN2 = 0) {
    unsigned char* ws = a.ws;
    const int* cnt = (const int*)(F.ctl + CW_CNT);
    LAS int* ulist = (LAS int*)(F.lds + XTR_OFF + XTR_ULIST);
    LAS int* rowoff = (LAS int*)(F.lds + XTR_OFF + XTR_ROWOFF);
    LAS unsigned* gtab = (LAS unsigned*)(F.lds + XTR_OFF + XTR_GTAB);
    LAS int* cl = (LAS int*)(F.lds + XTR_OFF + XTR_ROWOFF + 160);
    LAS int* nu = (LAS int*)(F.lds + XTR_OFF + XTR_ROWOFF + 320);
    __syncthreads();
    if (F.tid < NE) cl[F.tid] = __hip_atomic_load(cnt + 64 * F.tid, __ATOMIC_RELAXED, __HIP_MEMORY_SCOPE_AGENT);
    __syncthreads();
    if (F.tid < (nN2 > 0 ? 128 : 64)) {
        const int i = F.tid & 63, w2 = F.tid >> 6;
        const int nN = w2 ? nN2 : nN_;
        LAS int* ulist = (LAS int*)(F.lds + XTR_OFF + XTR_ULIST) + 64 * w2;
        const int c8 = (F.G % 8 == 0), per = c8 ? F.G / 8 : F.G, x = c8 ? (int)(blockIdx.x % 8) : 0, j = c8 ? (int)(blockIdx.x / 8) : (int)blockIdx.x;
        int U = 0;
#pragma unroll
        for (int e = 0; e < NE; ++e) U += ((cl[e] + 255) >> 8) * nN;
        const int Q = U / F.G, R = U - Q * F.G, s = x * per + j;
        const bool split = (2 * R <= F.G);
        int L = (i * 8 + x) * per + j, half = -1;
        if (!c8) L = i * F.G + j;
        if (i == Q && split) { L = Q * F.G + (s >> 1); half = s & 1; if (s >= 2 * R) L = U; }
        if (i > Q) L = U;
        int base = 0, ro = 0, es = -1, bs = 0, ros = 0, cs = 0;
#pragma unroll
        for (int e = 0; e < NE; ++e) { const int c = cl[e], mt = (c + 255) >> 8, ue = mt * nN;
            if (es < 0 && L < base + ue) { es = e; bs = base; ros = ro; cs = c; }
            if (F.tid == 0) rowoff[e] = ro;
            base += ue; ro += mt * 256; }
        if (F.tid == 0) rowoff[NE] = ro;
        bool valid = (i < MOE_MAXU && es >= 0 && L < U);
        int pm2 = 0, pn = 0, rows = 0;
        if (valid) {
            const int mt = (cs + 255) >> 8, r = L - bs, mi = r % mt; pn = r / mt;
            pm2 = ros / 128 + 2 * mi; rows = min(256, cs - mi * 256);
            if (half == 0) rows = min(rows, 128);
            if (half == 1) { pm2 += 1; rows -= 128; }
            valid = rows > 0;
        }
        const unsigned long long vm = __ballot(valid);
        if (valid) { const int k = __popcll(vm & ((1ull << i) - 1ull));
            ulist[4 * k + 0] = es; ulist[4 * k + 1] = pm2; ulist[4 * k + 2] = pn; ulist[4 * k + 3] = rows; }
        if (i == 0) nu[w2] = __popcll(vm);
    }
    __syncthreads();
    const int n = *nu;
    if (gather) {
        const int* row_tok = (const int*)(ws + WS_ROWTOK);
        for (int i = F.tid; i < n * 256; i += NWAVES * 64) {
            const int ui = i >> 8, r = i & 255, e = ulist[4 * ui], mi = ulist[4 * ui + 1] - rowoff[e] / 128, rows = ulist[4 * ui + 3];
            const int idx = mi * 128 + (r < rows ? r : 0);
            gtab[i] = (unsigned)row_tok[e * CAP + idx] * (unsigned)DM;
        }
    }
    __syncthreads();
    return n;
}

namespace pg8 {
struct EpiGateUp {
    static constexpr bool PERM = true;
    unsigned char* act; const float* bias; const float* row_rs; const LAS int* rowoff;
    __device__ __forceinline__ void hook(f32x4 (&)[2][2][4][2], const Unit&, int, int, int, int) const {}
    __device__ __forceinline__ void operator()(f32x4 (&acc)[2][2][4][2], const Unit& u, int wr, int wc, int fr, int fq) const {
        const int rl0 = wr * 64 + fr, col0 = u.pn * BM + wc * 32 + 8 * fq;
        const int mi = u.pm - __builtin_amdgcn_readfirstlane(rowoff[u.e]) / 128;
        const float* bp = bias + (size_t)u.e * (2 * DFF) + col0;
        f32x4 bv[2][2];
#pragma unroll
        for (int bj = 0; bj < 2; ++bj)
#pragma unroll
            for (int n = 0; n < 2; ++n) { const f32x4 b = *(const GAS f32x4*)(bp + bj * HALF + 4 * n); bv[bj][n] = (f32x4){b[0], b[2], b[1], b[3]}; }
        float rsv[2][4];
#pragma unroll
        for (int ai = 0; ai < 2; ++ai)
#pragma unroll
            for (int m = 0; m < 4; ++m) rsv[ai][m] = row_rs[(size_t)u.e * CAP + mi * 128 + rl0 + ai * HALF + m * 16] * (1.f / 64.f);
#pragma unroll
        for (int ai = 0; ai < 2; ++ai) {
            if (ai == 1 && u.rows <= HALF) break;
#pragma unroll
            for (int m = 0; m < 4; ++m) {
                const int rl = rl0 + ai * HALF + m * 16;
                const float rs = rsv[ai][m];
                unsigned char* orow = act + (size_t)(u.pm * HALF + rl) * DFF + (col0 >> 1);
#pragma unroll
                for (int bj = 0; bj < 2; ++bj) {
                    f32x2 o[2];
#pragma unroll
                    for (int n = 0; n < 2; ++n) {
                        const f32x4 v = acc[ai][bj][m][n] * rs + bv[bj][n];
                        f32x2 gt = (f32x2){fminf(v[0], 7.f), fminf(v[1], 7.f)}, up = (f32x2){fminf(fmaxf(v[2], -7.f), 7.f), fminf(fmaxf(v[3], -7.f), 7.f)};
                        const f32x2 t = gt * (-1.702f * 1.4426950408889634f);
                        const f32x2 d = (f32x2){__builtin_amdgcn_exp2f(t.x), __builtin_amdgcn_exp2f(t.y)} + 1.f;
                        const f32x2 sg = (f32x2){__builtin_amdgcn_rcpf(d.x), __builtin_amdgcn_rcpf(d.y)};
                        o[n] = (up + 1.f) * (gt * sg);
                    }
                    { int w = __builtin_amdgcn_cvt_pk_fp8_f32(o[0].x, o[0].y, 0, false); w = __builtin_amdgcn_cvt_pk_fp8_f32(o[1].x, o[1].y, w, true); *(GAS unsigned*)(orow + bj * (HALF / 2)) = (unsigned)w; }
                }
            }
        }
    }
};
struct EpiDown {
    static constexpr bool PERM = true;
    unsigned char* y; const float* bias;
    __device__ __forceinline__ void hook(f32x4 (&)[2][2][4][2], const Unit&, int, int, int, int) const {}
    __device__ __forceinline__ void operator()(f32x4 (&acc)[2][2][4][2], const Unit& u, int wr, int wc, int fr, int fq) const {
        const int rl0 = wr * 64 + fr, col0 = u.pn * BM + wc * 32 + 8 * fq;
        const float* bp = bias + (size_t)u.e * DM + col0;
        f32x4 bv[2][2];
#pragma unroll
        for (int bj = 0; bj < 2; ++bj) { bv[bj][0] = *(const GAS f32x4*)(bp + bj * HALF); bv[bj][1] = *(const GAS f32x4*)(bp + bj * HALF + 4); }
#pragma unroll
        for (int ai = 0; ai < 2; ++ai) {
            if (ai == 1 && u.rows <= HALF) break;
#pragma unroll
            for (int m = 0; m < 4; ++m) {
                const int rl = rl0 + ai * HALF + m * 16;
                unsigned char* orow = y + (size_t)(u.pm * HALF + rl) * DM + col0;
#pragma unroll
                for (int bj = 0; bj < 2; ++bj) { const f32x4 v0 = acc[ai][bj][m][0] * (1.f / 64.f) + bv[bj][0], v1 = acc[ai][bj][m][1] * (1.f / 64.f) + bv[bj][1];
                    int w0 = __builtin_amdgcn_cvt_pk_fp8_f32(v0[0], v0[1], 0, false); w0 = __builtin_amdgcn_cvt_pk_fp8_f32(v0[2], v0[3], w0, true);
                    int w1 = __builtin_amdgcn_cvt_pk_fp8_f32(v1[0], v1[1], 0, false); w1 = __builtin_amdgcn_cvt_pk_fp8_f32(v1[2], v1[3], w1, true);
                    *(GAS u32x2*)(orow + bj * HALF) = (u32x2){(unsigned)w0, (unsigned)w1}; }
            }
        }
    }
};
struct EpiPlain {
    static constexpr bool PERM = true;
    bf16_t* O; int ldc;
    __device__ __forceinline__ void hook(f32x4 (&)[2][2][4][2], const Unit&, int, int, int, int) const {}
    __device__ __forceinline__ void operator()(f32x4 (&acc)[2][2][4][2], const Unit& u, int wr, int wc, int fr, int fq) const {
        const int row0 = u.pm * BM + wr * 64 + fr, col0 = u.pn * BM + wc * 32 + 8 * fq;
#pragma unroll
        for (int ai = 0; ai < 2; ++ai)
#pragma unroll
            for (int m = 0; m < 4; ++m) { bf16_t* orow = O + (size_t)(row0 + ai * HALF + m * 16) * ldc + col0;
#pragma unroll
                for (int bj = 0; bj < 2; ++bj) { const f32x4 v0 = acc[ai][bj][m][0], v1 = acc[ai][bj][m][1];
                    *(GAS u32x4*)(orow + bj * HALF) = (u32x4){cvt_pk_bf16(v0[0], v0[1]), cvt_pk_bf16(v0[2], v0[3]), cvt_pk_bf16(v1[0], v1[1]), cvt_pk_bf16(v1[2], v1[3])}; } }
    }
};
struct EpiPle {
    static constexpr bool PERM = true;
    const bf16_t* hin; float* out; const bf16_t* pe; const float* rs3;
    __device__ __forceinline__ void hook(f32x4 (&)[2][2][4][2], const Unit&, int, int, int, int) const {}
    __device__ __forceinline__ void operator()(f32x4 (&acc)[2][2][4][2], const Unit& u, int wr, int wc, int fr, int fq) const {
        const int row0 = u.pm * BM + wr * 64 + fr, col0 = u.pn * BM + wc * 32 + 8 * fq;
        float rsv[2][4];
#pragma unroll
        for (int ai = 0; ai < 2; ++ai)
#pragma unroll
            for (int m = 0; m < 4; ++m) rsv[ai][m] = rs3[row0 + ai * HALF + m * 16] * (1.f / 64.f);
#pragma unroll
        for (int ai = 0; ai < 2; ++ai)
#pragma unroll
            for (int mp = 0; mp < 2; ++mp) {
                u32x4 hq[2][2], pv[2][2];
#pragma unroll
                for (int mm = 0; mm < 2; ++mm) { const size_t off = (size_t)(row0 + ai * HALF + (2 * mp + mm) * 16) * DM + col0;
#pragma unroll
                    for (int bj = 0; bj < 2; ++bj) { pv[mm][bj] = *(const GAS u32x4*)(pe + off + bj * HALF); hq[mm][bj] = *(const GAS u32x4*)(hin + off + bj * HALF); } }
#pragma unroll
                for (int mm = 0; mm < 2; ++mm) { const int m = 2 * mp + mm; const float rs = rsv[ai][m];
                    const size_t off = (size_t)(row0 + ai * HALF + m * 16) * DM + col0;
#pragma unroll
                    for (int bj = 0; bj < 2; ++bj) {
                        const u32x4 h4 = hq[mm][bj]; f32x4 h0 = (f32x4){bflo(h4.x), bfhi(h4.x), bflo(h4.y), bfhi(h4.y)}, h1 = (f32x4){bflo(h4.z), bfhi(h4.z), bflo(h4.w), bfhi(h4.w)}; const u32x4 p4 = pv[mm][bj];
                        const f32x4 a0 = acc[ai][bj][m][0] * rs, a1 = acc[ai][bj][m][1] * rs;
                        const float pf[8] = {bflo(p4.x), bfhi(p4.x), bflo(p4.y), bfhi(p4.y), bflo(p4.z), bfhi(p4.z), bflo(p4.w), bfhi(p4.w)};
#pragma unroll
                        for (int i = 0; i < 4; ++i) {
                            h0[i] += pf[i] * __builtin_amdgcn_rcpf(1.f + __builtin_amdgcn_exp2f(a0[i] * -1.4426950408889634f));
                            h1[i] += pf[4 + i] * __builtin_amdgcn_rcpf(1.f + __builtin_amdgcn_exp2f(a1[i] * -1.4426950408889634f)); }
                        *(GAS f32x4*)(out + off + bj * HALF) = h0; *(GAS f32x4*)(out + off + bj * HALF + 4) = h1;
                    } }
            }
    }
};
}

__device__ __forceinline__ void p7_combine(Frame& F, const Args& a) {
    unsigned char* ws = a.ws;
    const int* cnt = (const int*)(F.ctl + CW_CNT);
    LAS int* rowoff = (LAS int*)(F.lds + XTR_OFF + XTR_ROWOFF);
    __syncthreads();
    if (F.tid < 64) {
        const int c = (F.tid < NE) ? __hip_atomic_load(cnt + 64 * (F.tid & 31), __ATOMIC_RELAXED, __HIP_MEMORY_SCOPE_AGENT) : 0;
        const int pr = ((c + 255) >> 8) * 256; int incl = pr;
#pragma unroll
        for (int o = 1; o < 32; o <<= 1) { const int v = __shfl_up(incl, o); if ((F.tid & 63) >= o) incl += v; }
        if (F.tid <= NE) rowoff[F.tid] = incl - pr;
    }
    __syncthreads();
    const int* tokinfo = (const int*)(ws + WS_TOKINFO); const float* tokgate = (const float*)(ws + WS_TOKINFO + 131072);
    const unsigned char* y = (const unsigned char*)(ws + WS_Y);
    const bf16_t* hin = (const bf16_t*)(ws + WS_HF); bf16_t* out = (bf16_t*)(ws + WS_H2F); unsigned char* h2b = (unsigned char*)(ws + WS_H2B); float* rs3 = (float*)(ws + WS_RS + 32768);
    const int gw = F.vcu * NWAVES + F.wave, NGW = F.G * NWAVES;
    for (int tok = gw; tok < T; tok += NGW) {
        size_t yr[4]; float gk[4];
#pragma unroll
        for (int k = 0; k < 4; ++k) { const int inf = tokinfo[tok * 4 + k]; yr[k] = (size_t)(rowoff[inf >> 16] + (inf & 0xffff)) * DM; gk[k] = tokgate[tok * 4 + k]; }
        float ssq = 0.f;
        GAS u32x2* hp = (GAS u32x2*)(out + (size_t)tok * DM) + F.lane;
        GAS unsigned* bp = (GAS unsigned*)(h2b + (size_t)tok * DM) + F.lane;
        u32x2 hv[8]; unsigned yv[4][8];
#pragma unroll
        for (int j = 0; j < 8; ++j) { hv[j] = __builtin_nontemporal_load((const u32x2*)(hin + (size_t)tok * DM) + 64 * j + F.lane);
#pragma unroll
            for (int k = 0; k < 4; ++k) yv[k][j] = __builtin_nontemporal_load((const unsigned*)(y + yr[k]) + 64 * j + F.lane); }
#pragma unroll
        for (int j = 0; j < 8; ++j) {
            f32x4 v = (f32x4){bflo(hv[j].x), bfhi(hv[j].x), bflo(hv[j].y), bfhi(hv[j].y)};
#pragma unroll
            for (int k = 0; k < 4; ++k) { f32x2 lo, hi;
                asm volatile("v_cvt_pk_f32_fp8_e32 %0, %2\n\tv_cvt_pk_f32_fp8_sdwa %1, %2 src0_sel:WORD_1" : "=&v"(lo), "=&v"(hi) : "v"(yv[k][j]));
                v.x += gk[k] * lo.x; v.y += gk[k] * lo.y; v.z += gk[k] * hi.x; v.w += gk[k] * hi.y; }
            hp[64 * j] = (u32x2){cvt_pk_bf16(v.x, v.y), cvt_pk_bf16(v.z, v.w)}; { int w = __builtin_amdgcn_cvt_pk_fp8_f32(v.x, v.y, 0, false); w = __builtin_amdgcn_cvt_pk_fp8_f32(v.z, v.w, w, true); bp[64 * j] = (unsigned)w; }
            ssq += (v.x * v.x + v.y * v.y) + (v.z * v.z + v.w * v.w);
        }
        ssq = wave_sum(ssq);
        if (F.lane == 0) rs3[tok] = rsqrtf(ssq * (1.f / DM) + EPS);
    }
}
#ifndef CONV_ROWS_MASK
#define CONV_ROWS_MASK 0xa94a5294u
#endif
#ifndef PH_MOE_CONVERT
#define PH_MOE_CONVERT 1
#endif
__global__ void __launch_bounds__(NWAVES * 64, 2) mk_fwd(Args args) {
    extern __shared__ __attribute__((aligned(16))) unsigned char lds_raw[];
    Frame F;
    F.lds = (LAS unsigned char*)lds_raw;
    F.MISC = (volatile LAS unsigned*)(F.lds + MISC_OFF);
    F.tid = threadIdx.x; F.lane = F.tid & 63; F.wave = __builtin_amdgcn_readfirstlane(F.tid >> 6);
    F.G = gridDim.x; { const int bx = blockIdx.x; F.vcu = (F.G % 8 == 0) ? (bx % 8) * (F.G / 8) + bx / 8 : bx; }
    { const int bx = blockIdx.x; const bool split = (F.G == 256); const int row = bx >> 3; constexpr unsigned CONV_MASK = CONV_ROWS_MASK;
      F.conv = split && ((CONV_MASK >> row) & 1u); F.cG = split ? 8 * (32 - __builtin_popcount(CONV_MASK)) : F.G;
      const int crow = row - __builtin_popcount(CONV_MASK & ((1u << row) - 1u));
      F.cidx = split ? ((crow << 3) | (bx & 7)) : bx;
      F.cvcu = (F.cG % 8 == 0) ? (F.cidx % 8) * (F.cG / 8) + F.cidx / 8 : F.cidx; }
    unsigned char* ws = args.ws;
    F.ctl = (unsigned*)(ws + WS_CTL);
    for (int u = F.tid; u < 64; u += NWAVES * 64) F.MISC[u] = 0u;
    __syncthreads();
    XcdBarrier bar = xcd_barrier_post(F.ctl + CW_BAR, F.MISC + 8, (unsigned)F.G);
    XcdBarrier bar2; bar2.bar = F.ctl + CW_BAR2; bar2.x = 0; bar2.st = F.MISC + 24; bar2.total = (unsigned)F.cG;
    if (!F.conv) bar2 = xcd_barrier_post(F.ctl + CW_BAR2, F.MISC + 24, (unsigned)F.cG);
    const int lo = args.ph_lo, hi = args.ph_hi;
#define IN(k) (lo <= (k) && (k) < hi)
#define BOTH(k) (IN(k) && IN((k) + 1))

    if (IN(0)) {
        if (F.cG < F.G) { if (!F.conv) { Frame F2 = F; F2.vcu = F.cvcu; F2.G = F.cG; p0_prologue(F2, args); if (BOTH(0)) xcd_barrier(bar2); } }
        else { p0_prologue(F, args); if (BOTH(0)) xcd_barrier(bar); }
    }
    if (IN(1)) { REFRESH();
        if (F.conv) {
            moe_convert_pull(F, args);
        } else {
            {
                pg8::DenseOrder S; S.init(ws + WS_XB, ws + WS_WIN, T, DIN, DM * 2, F.cG, F.cidx);
                pg8::EpiProj E{(bf16_t*)(ws + WS_PROJ), (float*)(ws + WS_STATS)};
                pg8::gemm_phase<pg8::EpiProj, pg8::DenseOrder, true, false, false>(F.lds, DM * 2, S, E);
            }
            {
                pg8::DenseOrder S2; S2.init(ws + WS_PB, ws + WS_WPLE, T, DM, DPLE * 2, F.cG, F.cidx);
                pg8::EpiPlain E2{(bf16_t*)(ws + WS_PE), DM};
                int kple = DPLE * 2; asm volatile("" : "+s"(kple));
                pg8::gemm_phase<pg8::EpiPlain, pg8::DenseOrder, true, false, false>(F.lds, kple, S2, E2);
            }
            xcd_barrier(bar2); REFRESH();
            p2_mixers(F, args);
            xcd_barrier(bar2);
#ifndef P3_FILL
#define P3_FILL 12
#endif
            {
                pg8::DenseOrder S; S.init(ws + WS_MG, ws + WS_WOUT, T, DM, DM * 2, F.cG, F.cidx);
                LAS f32x2* tab = (LAS f32x2*)(F.lds + XTR_OFF);
                pg8::p3_rowtab(tab, S, (const float*)(ws + WS_ASS), (const float*)(ws + WS_SSS), 8);
                pg8::EpiOut E{args.in[0], (bf16_t*)(ws + WS_HF), (unsigned char*)(ws + WS_HB), tab};
                pg8::gemm_phase<pg8::EpiOut, pg8::DenseOrder, true, false, true>(F.lds, DM * 2, S, E);
            }
            if (F.cG < F.G && F.cidx >= (T / 256) * (DM / 256) - F.cG) { REFRESH(); moe_convert_pull(F, args, P3_FILL); }
            xcd_barrier(bar2); REFRESH();
            p4_router(F, args);
            REFRESH();
            moe_convert_pull(F, args);
        }
        if (BOTH(1) || IN(5)) xcd_barrier(bar);
    }
    if (IN(5)) { REFRESH();
        const int n = moe_build(F, args, 2 * DFF / 256, true, DM / 256);
        MoeOrder S{(const char*)(ws + WS_HB), (const char*)(ws + WS_WGU), (size_t)2 * DFF * DM, DM, true, (const LAS int*)(F.lds + XTR_OFF + XTR_ULIST), (const LAS unsigned*)(F.lds + XTR_OFF + XTR_GTAB), n};
        pg8::EpiGateUp E{(unsigned char*)(ws + WS_ACT), args.in[18], (const float*)(ws + WS_ROWRS), (const LAS int*)(F.lds + XTR_OFF + XTR_ROWOFF)};
        pg8::gemm_phase<pg8::EpiGateUp, MoeOrder, true, true, false, true, true>(F.lds, DM, S, E);
        if (BOTH(5)) xcd_barrier(bar);
    }
    if (IN(6)) { REFRESH();
        const bool pre = IN(5);
        const int n = pre ? *(const LAS int*)(F.lds + XTR_OFF + XTR_ROWOFF + 324) : moe_build(F, args, DM / 256, false);
        MoeOrder S{(const char*)(ws + WS_ACT), (const char*)(ws + WS_WDN), (size_t)DM * DFF, DFF, false, (const LAS int*)(F.lds + XTR_OFF + XTR_ULIST) + (pre ? 64 : 0), (const LAS unsigned*)(F.lds + XTR_OFF + XTR_GTAB), n};
        pg8::EpiDown E{(unsigned char*)(ws + WS_Y), args.in[20]};
        pg8::gemm_phase<pg8::EpiDown, MoeOrder, true, false, false, true, true>(F.lds, DFF, S, E);
        if (BOTH(6)) xcd_barrier(bar);
    }
    if (IN(7)) { REFRESH(); p7_combine(F, args); if (BOTH(7)) xcd_barrier(bar); }
    if (IN(8)) { REFRESH();
        pg8::DenseOrder S; S.init(ws + WS_H2B, ws + WS_WPG, T, DM, DM, F.G, (int)blockIdx.x);
        pg8::EpiPle E{(const bf16_t*)(ws + WS_H2F), args.out, (const bf16_t*)(ws + WS_PE), (const float*)(ws + WS_RS + 32768)};
        pg8::gemm_phase<pg8::EpiPle, pg8::DenseOrder, true, false, false, true>(F.lds, DM, S, E);
    }
#undef IN
#undef BOTH
}
extern "C" void kernel_launch(void* const* d_in, const int* in_sizes, int n_in, void* d_out, int out_size, void* d_ws, size_t ws_size, hipStream_t stream) {
    static int grid = 0;
    if (grid == 0) {
        int dev = 0, cus = 0;
        if (n_in != 24 || out_size != T * DM || ws_size < WS_END) { fprintf(stderr, "kernel_launch: built for 24 inputs, %d outputs, >= %zu bytes of workspace\n", T * DM, (size_t)WS_END); grid = -1; return; }
        if (hipGetDevice(&dev) != hipSuccess || hipDeviceGetAttribute(&cus, hipDeviceAttributeMultiprocessorCount, dev) != hipSuccess) { fprintf(stderr, "kernel_launch: device query failed\n"); grid = -1; return; }
        if (hipFuncSetAttribute((const void*)mk_fwd, hipFuncAttributeMaxDynamicSharedMemorySize, LDS_BYTES) != hipSuccess) { fprintf(stderr, "kernel_launch: hipFuncSetAttribute failed\n"); grid = -1; return; }
        (void)hipGetLastError();
        grid = cus;
    }
    if (grid < 0) return;
    (void)hipMemsetAsync((char*)d_ws + WS_CTL, 0, CTL_ZERO_BYTES, stream);
    Args a{};
    for (int i = 0; i < 24; ++i) a.in[i] = (const float*)d_in[i];
    a.out = (float*)d_out; a.ws = (unsigned char*)d_ws;
    a.ph_lo = 0; a.ph_hi = 9;
    hipLaunchKernelGGL(mk_fwd, dim3(grid), dim3(NWAVES * 64), LDS_BYTES, stream, a);
}
```
